# Optimizing an MI355X kernel written in HIP

```python
import math
import jax, jax.numpy as jnp
from jax import lax
import numpy as np

D_MODEL = 1024
BATCH = 2
SEQ = 8192
DEPTH = 1
DEC_BATCH = 128
DEC_SEQ = 1
PAST_LEN = 16384
PAGE_SIZE = 128

WINDOW = 128
ATT_BLOCK = 128
HEAD_DIM = 64
N_Q_HEADS = 8
N_KV_HEADS = 2
GQA_GROUP = N_Q_HEADS // N_KV_HEADS
ATT_WIDTH = N_Q_HEADS * HEAD_DIM
KV_WIDTH = N_KV_HEADS * HEAD_DIM
N_BUCKETS = 32
MAX_DISTANCE = WINDOW
M_HEADS = 4
M_DV = (D_MODEL // 2) // M_HEADS
M_DK = M_DV // 2
M_WIDTH = M_HEADS * M_DV
M_QK_WIDTH = M_HEADS * M_DK
MLSTM_CHUNK = 64
D_FF = -(-8 * D_MODEL // (3 * 256)) * 256
N_IN = ATT_WIDTH + 2 * KV_WIDTH + 2 * M_QK_WIDTH + 2 * M_WIDTH + 2 * M_HEADS + 2 * D_MODEL
EPS = 1e-6
NEG = -1e30

kernel_name = 'hybrid_swa_sink_mlstm_decoder_step'


def in_split_points():
    sizes = [ATT_WIDTH, KV_WIDTH, KV_WIDTH, M_QK_WIDTH, M_QK_WIDTH, M_WIDTH, M_WIDTH,
             M_HEADS, M_HEADS, D_MODEL, D_MODEL]
    return [int(s) for s in np.cumsum(sizes)[:-1]]


def rmsnorm(x, g):
    xf = x.astype(jnp.float32)
    y = xf * lax.rsqrt(jnp.mean(xf * xf, axis=-1, keepdims=True) + EPS)
    return (y * g.astype(jnp.float32)).astype(x.dtype)


def t5_bucket(dist):
    n = jnp.maximum(dist, 0)
    max_exact = N_BUCKETS // 2
    nf = jnp.maximum(n, 1).astype(jnp.float32)
    large = max_exact + (jnp.log(nf / max_exact) / math.log(MAX_DISTANCE / max_exact)
                         * (N_BUCKETS - max_exact)).astype(jnp.int32)
    large = jnp.minimum(large, N_BUCKETS - 1)
    return jnp.where(n < max_exact, n, large)


def sink_window_attention(q, k, v, dist, valid, rel_bias, sinks):
    qf = q.astype(jnp.float32) * (HEAD_DIM ** -0.5)
    s = jnp.einsum('...qhgd,...khd->...hgqk', qf, k.astype(jnp.float32))
    nq, nk = dist.shape
    bias = rel_bias.astype(jnp.float32)[t5_bucket(dist)]
    bias = jnp.transpose(bias, (2, 0, 1)).reshape(N_KV_HEADS, GQA_GROUP, nq, nk)
    s = jnp.where(valid, s + bias, NEG)
    sink = sinks.astype(jnp.float32).reshape(N_KV_HEADS, GQA_GROUP, 1, 1)
    m = jnp.maximum(jnp.max(s, axis=-1, keepdims=True), sink)
    p = jnp.exp(s - m)
    denom = jnp.sum(p, axis=-1, keepdims=True) + jnp.exp(sink - m)
    return jnp.einsum('...hgqk,...khd->...qhgd', p / denom, v.astype(jnp.float32))


def attn_prompt(q, k, v, rel_bias, sinks):
    bsz, s_len = q.shape[:2]
    nb = s_len // ATT_BLOCK
    qb = q.reshape(bsz, nb, ATT_BLOCK, N_KV_HEADS, GQA_GROUP, HEAD_DIM)

    def band(t):
        tb = t.reshape(bsz, nb, ATT_BLOCK, N_KV_HEADS, HEAD_DIM)
        prev = jnp.pad(tb, ((0, 0), (1, 0), (0, 0), (0, 0), (0, 0)))[:, :-1]
        return jnp.concatenate([prev, tb], axis=2)

    kb, vb = band(k), band(v)
    qi = jnp.arange(ATT_BLOCK)[:, None]
    kj = jnp.arange(2 * ATT_BLOCK)[None, :]
    dist = ATT_BLOCK + qi - kj
    blk = jnp.arange(nb)[:, None, None]
    valid = (dist >= 0) & (dist < WINDOW) & (blk * ATT_BLOCK - ATT_BLOCK + kj >= 0)
    o = sink_window_attention(qb, kb, vb, dist, valid[:, None, None], rel_bias, sinks)
    return o.reshape(bsz, s_len, ATT_WIDTH)


def attn_sample(q, k, v, buf_k, buf_v, rel_bias, sinks):
    bsz, s_len = q.shape[:2]
    wb = buf_k.shape[1]
    keys = jnp.concatenate([buf_k.astype(k.dtype), k], axis=1)
    vals = jnp.concatenate([buf_v.astype(v.dtype), v], axis=1)
    qi = jnp.arange(s_len)[:, None]
    kj = jnp.arange(wb + s_len)[None, :]
    dist = wb + qi - kj
    valid = (dist >= 0) & (dist < WINDOW)
    o = sink_window_attention(q, keys, vals, dist, valid, rel_bias, sinks)
    return o.reshape(bsz, s_len, ATT_WIDTH), keys[:, -wb:], vals[:, -wb:]


def mlstm_chunkwise(q, k, v, ig, lf, c0, n0, m0):
    bsz, s_len, nh, _ = q.shape
    L = math.gcd(s_len, MLSTM_CHUNK)
    nc = s_len // L

    def to_chunks(t):
        t = t.reshape((bsz, nc, L, nh) + t.shape[3:])
        return jnp.moveaxis(jnp.moveaxis(t, 1, 0), 3, 2)

    causal = jnp.tril(jnp.ones((L, L), dtype=bool))

    def step(carry, inp):
        c, n, m = carry
        qc, kc, vc, igc, lfc = inp
        b = jnp.cumsum(lfc, axis=-1)
        a = igc - b
        m_t = b + jnp.maximum(m[..., None], lax.cummax(a, axis=a.ndim - 1))
        log_d = a[..., None, :] + b[..., :, None] - m_t[..., :, None]
        d = jnp.exp(jnp.where(causal, log_d, NEG))
        inter = jnp.exp(m[..., None] + b - m_t)
        w = d * jnp.einsum('bhtd,bhsd->bhts', qc, kc)
        num = inter[..., None] * jnp.einsum('bhvd,bhtd->bhtv', c, qc) + jnp.einsum('bhts,bhsv->bhtv', w, vc)
        den = inter * jnp.einsum('bhd,bhtd->bht', n, qc) + jnp.sum(w, axis=-1)
        h = num / jnp.maximum(jnp.abs(den), jnp.exp(-m_t))[..., None]
        m_end = m_t[..., -1]
        w_s = jnp.exp(a + b[..., -1:] - m_end[..., None])
        decay = jnp.exp(m + b[..., -1] - m_end)
        c_new = decay[..., None, None] * c + jnp.einsum('bhs,bhsv,bhsd->bhvd', w_s, vc, kc)
        n_new = decay[..., None] * n + jnp.einsum('bhs,bhsd->bhd', w_s, kc)
        return (c_new, n_new, m_end), h

    xs = (to_chunks(q), to_chunks(k), to_chunks(v), to_chunks(ig), to_chunks(lf))
    (c1, n1, m1), hs = lax.scan(step, (c0, n0, m0), xs)
    hs = jnp.moveaxis(jnp.moveaxis(hs, 3, 2), 0, 1).reshape(bsz, s_len, nh, v.shape[-1])
    return hs, c1, n1, m1


def decoder_layer(x, buf_k, buf_v, c0, n0, m0, rel_bias, w_in, b_if, sinks, g_attn_norm, g_head,
                  w_att_out, w_mlstm_out, w_out, g_ffn_norm, w_gate, w_up, w_down):
    f32 = jnp.float32
    bsz, s_len, _ = x.shape
    h = rmsnorm(x, g_attn_norm)
    z = h @ w_in
    q_a, k_a, v_a, q_m, k_m, v_m, o_m, i_pre, f_pre, gate_a, gate_m = jnp.split(z, in_split_points(), axis=-1)
    q_a = q_a.reshape(bsz, s_len, N_KV_HEADS, GQA_GROUP, HEAD_DIM)
    k_a = k_a.reshape(bsz, s_len, N_KV_HEADS, HEAD_DIM)
    v_a = v_a.reshape(bsz, s_len, N_KV_HEADS, HEAD_DIM)
    if buf_k is None:
        y_att = attn_prompt(q_a, k_a, v_a, rel_bias, sinks)
        new_k, new_v = k_a[:, -WINDOW:], v_a[:, -WINDOW:]
    else:
        y_att, new_k, new_v = attn_sample(q_a, k_a, v_a, buf_k, buf_v, rel_bias, sinks)
    qm = q_m.astype(f32).reshape(bsz, s_len, M_HEADS, M_DK)
    km = k_m.astype(f32).reshape(bsz, s_len, M_HEADS, M_DK) * (M_DK ** -0.5)
    vm = v_m.astype(f32).reshape(bsz, s_len, M_HEADS, M_DV)
    ig = i_pre.astype(f32) + b_if[0].astype(f32)
    lf = jax.nn.log_sigmoid(f_pre.astype(f32) + b_if[1].astype(f32))
    if c0 is None:
        c0 = jnp.zeros((bsz, M_HEADS, M_DV, M_DK), f32)
        n0 = jnp.zeros((bsz, M_HEADS, M_DK), f32)
        m0 = jnp.zeros((bsz, M_HEADS), f32)
    hm, c1, n1, m1 = mlstm_chunkwise(qm, km, vm, ig, lf, c0.astype(f32), n0.astype(f32), m0.astype(f32))
    hm = hm * lax.rsqrt(jnp.mean(hm * hm, axis=-1, keepdims=True) + EPS)
    hm = hm.reshape(bsz, s_len, M_WIDTH) * g_head.astype(f32)
    y_mlstm = hm.astype(x.dtype) * jax.nn.sigmoid(o_m)
    y_a = y_att.astype(x.dtype) @ w_att_out
    y_m = y_mlstm @ w_mlstm_out
    mixed = jax.nn.sigmoid(gate_a) * y_a + jax.nn.sigmoid(gate_m) * y_m
    x = x + mixed @ w_out
    h2 = rmsnorm(x, g_ffn_norm)
    x = x + (jax.nn.silu(h2 @ w_gate) * (h2 @ w_up)) @ w_down
    return x, (new_k, new_v, c1, n1, m1)


def setup_inputs(seed: int = 0) -> dict:
    key = jax.random.key(seed)
    ks = jax.random.split(key, 24)
    f32 = jnp.float32

    def nrm(k, shape, scale):
        return scale * jax.random.normal(k, shape, f32)

    win_buf = min(WINDOW, PAST_LEN)
    b_if = jnp.stack([nrm(ks[9], (DEPTH, M_HEADS), 0.1),
                      jnp.linspace(3.0, 6.0, M_HEADS)[None, :] + nrm(ks[10], (DEPTH, M_HEADS), 0.1)], axis=1)
    return {
        'x_prompt': nrm(ks[0], (BATCH, SEQ, D_MODEL), 1.0),
        'x_sample': nrm(ks[1], (DEC_BATCH, DEC_SEQ, D_MODEL), 1.0),
        'cache_k_win': nrm(ks[2], (DEPTH, DEC_BATCH, win_buf, N_KV_HEADS, HEAD_DIM), 1.0),
        'cache_v_win': nrm(ks[3], (DEPTH, DEC_BATCH, win_buf, N_KV_HEADS, HEAD_DIM), 1.0),
        'state_mlstm_C': nrm(ks[4], (DEPTH, DEC_BATCH, M_HEADS, M_DV, M_DK), 0.1),
        'state_mlstm_n': nrm(ks[5], (DEPTH, DEC_BATCH, M_HEADS, M_DK), 0.1),
        'state_mlstm_m': nrm(ks[6], (DEPTH, DEC_BATCH, M_HEADS), 1.0),
        'rel_bias': nrm(ks[7], (N_BUCKETS, N_Q_HEADS), 0.1),
        'w_in': nrm(ks[8], (DEPTH, D_MODEL, N_IN), D_MODEL ** -0.5),
        'b_if': b_if,
        'sinks': nrm(ks[11], (DEPTH, N_Q_HEADS), 0.5),
        'g_attn_norm': 1.0 + nrm(ks[12], (DEPTH, D_MODEL), 0.05),
        'g_head': 1.0 + nrm(ks[13], (DEPTH, M_WIDTH), 0.05),
        'w_att_out': nrm(ks[14], (DEPTH, ATT_WIDTH, D_MODEL), ATT_WIDTH ** -0.5),
        'w_mlstm_out': nrm(ks[15], (DEPTH, M_WIDTH, D_MODEL), M_WIDTH ** -0.5),
        'w_out': nrm(ks[16], (DEPTH, D_MODEL, D_MODEL), D_MODEL ** -0.5),
        'g_ffn_norm': 1.0 + nrm(ks[17], (DEPTH, D_MODEL), 0.05),
        'w_gate': nrm(ks[18], (DEPTH, D_MODEL, D_FF), D_MODEL ** -0.5),
        'w_up': nrm(ks[19], (DEPTH, D_MODEL, D_FF), D_MODEL ** -0.5),
        'w_down': nrm(ks[20], (DEPTH, D_FF, D_MODEL), D_FF ** -0.5),
        'g_final': 1.0 + nrm(ks[21], (D_MODEL,), 0.05),
    }


def reference(x_prompt, x_sample, cache_k_win, cache_v_win, state_mlstm_C, state_mlstm_n, state_mlstm_m,
              rel_bias, w_in, b_if, sinks, g_attn_norm, g_head, w_att_out, w_mlstm_out, w_out,
              g_ffn_norm, w_gate, w_up, w_down, g_final):
    xp, xs = x_prompt, x_sample
    p_new, s_new = [], []
    for l in range(DEPTH):
        lw = (rel_bias, w_in[l], b_if[l], sinks[l], g_attn_norm[l], g_head[l], w_att_out[l],
              w_mlstm_out[l], w_out[l], g_ffn_norm[l], w_gate[l], w_up[l], w_down[l])
        xp, st_p = decoder_layer(xp, None, None, None, None, None, *lw)
        xs, st_s = decoder_layer(xs, cache_k_win[l], cache_v_win[l], state_mlstm_C[l],
                                 state_mlstm_n[l], state_mlstm_m[l], *lw)
        p_new.append(st_p)
        s_new.append(st_s)
    y_prompt = rmsnorm(xp, g_final)
    y_sample = rmsnorm(xs, g_final)
    p_k, p_v, p_c, p_n, p_m = [jnp.stack(a) for a in zip(*p_new)]
    s_k, s_v, s_c, s_n, s_m = [jnp.stack(a) for a in zip(*s_new)]
    return (y_prompt, y_sample, p_k, p_v, p_c, p_n, p_m, s_k, s_v, s_c, s_n, s_m)
```

```cpp
#include <hip/hip_runtime.h>
#include <cstdio>
#include <cstdint>

constexpr int DM = 1024, SEQ = 8192, NTOK_P = 16384, NSAMP = 128, NROWS = NTOK_P + NSAMP, MPAD = 16640;
constexpr int NIN = 4360, NZ = 2304, NG1 = 4352, DFF = 2816, NFF2 = 5632;
constexpr int ZC_QA = 0, ZC_KA = 512, ZC_VA = 640, ZC_QM = 768, ZC_KM = 1024, ZC_VM = 1280, ZC_OM = 1792;
constexpr int WC_IF = 2304, WC_GA = 2312, WC_GM = 3336;
constexpr float EPS = 1e-6f;
constexpr size_t OFF_Y = 0, OFF_PK = 16908288, OFF_PV = 16941056, OFF_PC = 16973824, OFF_PN = 17039360, OFF_PM = 17039872,
                 OFF_SK = 17039880, OFF_SV = 19137032, OFF_SC = 21234184, OFF_SN = 25428488, OFF_SM = 25461256, OUT_END = 25461768;

namespace pg8 {
#define PG8_LAS __attribute__((address_space(3)))
typedef unsigned short bf16_t;
typedef short bf16x8 __attribute__((ext_vector_type(8)));
typedef float f32x4 __attribute__((ext_vector_type(4)));
typedef unsigned u32x4 __attribute__((ext_vector_type(4)));
typedef unsigned u32x2 __attribute__((ext_vector_type(2)));
constexpr int BM = 256, BK = 64, HALF = 128, HTB = HALF * BK * 2, STAGE_BYTES = 8 * HTB, NXCD = 8, WGM = 8;

__host__ __device__ __forceinline__ int lds_byte(int r, int c) { const int st = (r >> 4) * 2 + (c >> 5), rr = r & 15, cc = c & 31, ob = rr * 64 + cc * 2; return st * 1024 + (ob ^ (((ob >> 9) & 1) << 5)); }
__host__ __device__ __forceinline__ void stage_rc(int b, int& R, int& C) { const int st = b / 1024, sb = b % 1024, swz = sb ^ (((sb >> 9) & 1) << 5); R = (st >> 1) * 16 + swz / 64; C = (st & 1) * 32 + (swz % 64) / 2; }
__host__ __device__ __forceinline__ int perm32(int rho) { const int n = rho >> 4, i = rho & 15; return 8 * (i >> 2) + 4 * n + (i & 3); }

struct Unit { int pm, pn; };
struct Gemm { const bf16_t* A; const bf16_t* Bt; int M, N, K; };

struct StaticOrder {
    int nM, nN, nwg, G, c;
    __host__ __device__ void init(int M, int N, int G_, int c_) { nM = M / BM; nN = N / BM; nwg = nM * nN; G = G_; c = c_; }
    __host__ __device__ bool next(int i, Unit& u) const {
        const long L = (long)i * G + c; if (L >= nwg) return false;
        int wgid = (int)L; { const int q = nwg / NXCD, r = nwg % NXCD, xcd = wgid % NXCD, off = wgid / NXCD; wgid = (xcd < r ? xcd * (q + 1) : r * (q + 1) + (xcd - r) * q) + off; }
        const int nig = WGM * nN, gid = wgid / nig, fm = gid * WGM, gsz = (nM - fm) < WGM ? (nM - fm) : WGM;
        u.pm = fm + ((wgid % nig) % gsz); u.pn = (wgid % nig) / gsz; return true;
    }
    __device__ __forceinline__ void a_ready(const Unit&) const {}
    __device__ __forceinline__ void done(const Unit&) const {}
};

__device__ __forceinline__ unsigned cvt_pk_bf16(float lo, float hi) { unsigned r; asm volatile("v_cvt_pk_bf16_f32 %0, %1, %2" : "=v"(r) : "v"(lo), "v"(hi)); return r; }
__device__ __forceinline__ float bf_lo(unsigned w) { return __uint_as_float(w << 16); }
__device__ __forceinline__ float bf_hi(unsigned w) { return __uint_as_float(w & 0xffff0000u); }
__device__ __forceinline__ float sigmoidf_(float x) { return 1.0f / (1.0f + __expf(-x)); }


struct EpiIn {
    static constexpr bool PERM = false, AFTER_DRAIN = false;
    bf16_t* Z; bf16_t* Rb; bf16_t* SMb; float* out;
    __device__ __forceinline__ void mid(f32x4 (&)[2][2][4][2], const Unit&, int, int, int, int) const {}
    __device__ __forceinline__ void operator()(const f32x4 (&acc)[2][2][4][2], const Unit& u, int wr, int wc, int fr, int fq) const {
        const int row0 = u.pm * BM + wr * 64 + fr;
        if (u.pn < 9) {
            const int col0 = u.pn * BM + wc * 32 + 4 * fq;
#pragma unroll
            for (int ai = 0; ai < 2; ++ai)
#pragma unroll
                for (int m = 0; m < 4; ++m) { const int row = row0 + ai * HALF + m * 16; bf16_t* rowp = Z + (size_t)row * NZ + col0;
#pragma unroll
                    for (int bj = 0; bj < 2; ++bj)
#pragma unroll
                        for (int n = 0; n < 2; ++n) { const f32x4 v = acc[ai][bj][m][n]; u32x2 w; w.x = cvt_pk_bf16(v[0], v[1]); w.y = cvt_pk_bf16(v[2], v[3]);
                            *(u32x2*)(rowp + bj * HALF + n * 16) = w; } }
            if (u.pn == 2) {
#pragma unroll
                for (int ai = 0; ai < 2; ++ai)
#pragma unroll
                    for (int m = 0; m < 4; ++m) { const int row = row0 + ai * HALF + m * 16;
                        float* kp = nullptr; float* vp = nullptr;
                        if (row < NTOK_P) { const int b = row >> 13, t = row & (SEQ - 1); if (t >= SEQ - 128) { const size_t o = ((size_t)(b * 128 + (t - (SEQ - 128)))) * 128; kp = out + OFF_PK + o; vp = out + OFF_PV + o; } }
                        else if (row < NROWS) { const size_t o = ((size_t)((row - NTOK_P) * 128 + 127)) * 128; kp = out + OFF_SK + o; vp = out + OFF_SV + o; }
                        if (kp) {
#pragma unroll
                            for (int n = 0; n < 2; ++n) { const int c = wc * 32 + n * 16 + 4 * fq; *(f32x4*)(kp + c) = acc[ai][0][m][n]; *(f32x4*)(vp + c) = acc[ai][1][m][n]; } } }
            }
        } else {
            const int ch0 = (u.pn - 9) * 128 + wc * 32 + 4 * fq;
#pragma unroll
            for (int ai = 0; ai < 2; ++ai)
#pragma unroll
                for (int m = 0; m < 4; ++m) { const int row = row0 + ai * HALF + m * 16;
#pragma unroll
                    for (int n = 0; n < 2; ++n) { const f32x4 ga = acc[ai][0][m][n], gm = acc[ai][1][m][n]; float r[4], s[4];
#pragma unroll
                        for (int e = 0; e < 4; ++e) { const float ea = __expf(-ga[e]), em = __expf(-gm[e]); s[e] = 1.0f / (1.0f + em); r[e] = (1.0f + em) / (1.0f + ea); }
                        u32x2 wr_, ws_; wr_.x = cvt_pk_bf16(r[0], r[1]); wr_.y = cvt_pk_bf16(r[2], r[3]); ws_.x = cvt_pk_bf16(s[0], s[1]); ws_.y = cvt_pk_bf16(s[2], s[3]);
                        const size_t o = (size_t)row * DM + ch0 + n * 16; *(u32x2*)(Rb + o) = wr_; *(u32x2*)(SMb + o) = ws_; } }
        }
    }
};
struct EpiMix {
    static constexpr bool PERM = false, AFTER_DRAIN = false;
    const bf16_t* Rb; const bf16_t* SMb; bf16_t* MIX;
    __device__ __forceinline__ void mid(f32x4 (&acc)[2][2][4][2], const Unit& u, int wr, int wc, int fr, int fq) const {
        const int row0 = u.pm * BM + wr * 64 + fr, col0 = u.pn * BM + wc * 32 + 4 * fq;
#pragma unroll
        for (int ai = 0; ai < 2; ++ai)
#pragma unroll
            for (int m = 0; m < 4; ++m) { const bf16_t* rp = Rb + (size_t)(row0 + ai * HALF + m * 16) * DM + col0;
#pragma unroll
                for (int bj = 0; bj < 2; ++bj)
#pragma unroll
                    for (int n = 0; n < 2; ++n) { const u32x2 w = *(const u32x2*)(rp + bj * HALF + n * 16); f32x4 r; r[0] = bf_lo(w.x); r[1] = bf_hi(w.x); r[2] = bf_lo(w.y); r[3] = bf_hi(w.y);
                        acc[ai][bj][m][n] = acc[ai][bj][m][n] * r; }
                asm volatile("" ::: "memory"); }
    }
    __device__ __forceinline__ void operator()(const f32x4 (&acc)[2][2][4][2], const Unit& u, int wr, int wc, int fr, int fq) const {
        const int row0 = u.pm * BM + wr * 64 + fr, col0 = u.pn * BM + wc * 32 + 4 * fq;
#pragma unroll
        for (int ai = 0; ai < 2; ++ai)
#pragma unroll
            for (int m = 0; m < 4; ++m) { const size_t ro = (size_t)(row0 + ai * HALF + m * 16) * DM + col0;
#pragma unroll
                for (int bj = 0; bj < 2; ++bj)
#pragma unroll
                    for (int n = 0; n < 2; ++n) { const u32x2 w = *(const u32x2*)(SMb + ro + bj * HALF + n * 16); const f32x4 v = acc[ai][bj][m][n];
                        u32x2 o; o.x = cvt_pk_bf16(v[0] * bf_lo(w.x), v[1] * bf_hi(w.x)); o.y = cvt_pk_bf16(v[2] * bf_lo(w.y), v[3] * bf_hi(w.y));
                        *(u32x2*)(MIX + ro + bj * HALF + n * 16) = o; }
                asm volatile("" ::: "memory"); }
    }
};
struct EpiRes {
    static constexpr bool PERM = false, AFTER_DRAIN = false;
    const float* bp; const float* bs; float* X;
    __device__ __forceinline__ void mid(f32x4 (&)[2][2][4][2], const Unit&, int, int, int, int) const {}
    __device__ __forceinline__ void operator()(const f32x4 (&acc)[2][2][4][2], const Unit& u, int wr, int wc, int fr, int fq) const {
        const int row0 = u.pm * BM + wr * 64 + fr, col0 = u.pn * BM + wc * 32 + 4 * fq;
#pragma unroll
        for (int ai = 0; ai < 2; ++ai)
#pragma unroll
            for (int m = 0; m < 4; ++m) { const int row = row0 + ai * HALF + m * 16;
                if (row < NROWS) { const float* b = (row < NTOK_P ? bp + (size_t)row * DM : bs + (size_t)(row - NTOK_P) * DM) + col0; float* xo = X + (size_t)row * DM + col0;
#pragma unroll
                    for (int bj = 0; bj < 2; ++bj)
#pragma unroll
                        for (int n = 0; n < 2; ++n) { const f32x4 bv = *(const f32x4*)(b + bj * HALF + n * 16); *(f32x4*)(xo + bj * HALF + n * 16) = bv + acc[ai][bj][m][n]; } } }
    }
};
struct EpiSwiglu {
    static constexpr bool PERM = false, AFTER_DRAIN = false;
    bf16_t* ACT;
    __device__ __forceinline__ void mid(f32x4 (&)[2][2][4][2], const Unit&, int, int, int, int) const {}
    __device__ __forceinline__ void operator()(const f32x4 (&acc)[2][2][4][2], const Unit& u, int wr, int wc, int fr, int fq) const {
        const int row0 = u.pm * BM + wr * 64 + fr, ch0 = u.pn * 128 + wc * 32 + 4 * fq;
#pragma unroll
        for (int ai = 0; ai < 2; ++ai)
#pragma unroll
            for (int m = 0; m < 4; ++m) { bf16_t* rowp = ACT + (size_t)(row0 + ai * HALF + m * 16) * DFF + ch0;
#pragma unroll
                for (int n = 0; n < 2; ++n) { const f32x4 g = acc[ai][0][m][n], up = acc[ai][1][m][n]; float a[4];
#pragma unroll
                    for (int e = 0; e < 4; ++e) a[e] = g[e] * sigmoidf_(g[e]) * up[e];
                    u32x2 w; w.x = cvt_pk_bf16(a[0], a[1]); w.y = cvt_pk_bf16(a[2], a[3]); *(u32x2*)(rowp + n * 16) = w; } }
    }
};

template <class Epi, class Sched, bool ALIGN_EPI = false, bool SP2 = false, int MIDT = 0>
__device__ __forceinline__ void gemm_phase(PG8_LAS unsigned char* lds, const Gemm g, const Sched& S, const Epi& E, const int wid, const int lane) {
    const int tid = wid * 64 + lane, wr = wid >> 2, wc = wid & 3, fr = lane & 15, fq = lane >> 4;
    const int K = g.K, nt = K / BK;
    unsigned voffA[2], voffB[2];
#pragma unroll
    for (int i = 0; i < 2; ++i) { int R, C; stage_rc(tid * 16 + i * 8192, R, C); const int Rb = Epi::PERM ? ((R & ~31) + perm32(R & 31)) : R;
        voffA[i] = (unsigned)(R * K + C) * 2u; voffB[i] = (unsigned)(Rb * K + C) * 2u; }
    const size_t kstep = (size_t)(BK * 2);
    const size_t hstep = (size_t)HALF * K * 2;
    const size_t tstep = 2 * hstep;
    const unsigned ldsw = (unsigned)wid * 1024u;
    const int aoff = lds_byte(wr * 64 + fr, fq * 8), boff = lds_byte(wc * 32 + fr, fq * 8);
#define PG8_SA(b, h) (((b) * 2 + (h)) * HTB)
#define PG8_SB(b, h) ((4 + (b) * 2 + (h)) * HTB)
#define PG8_STAGE(bufoff, gbase, voff) do { _Pragma("unroll") for (int _i = 0; _i < 2; ++_i) \
        __builtin_amdgcn_global_load_lds((const unsigned*)((const char*)(gbase) + (voff)[_i]), (PG8_LAS unsigned*)(lds + (bufoff) + ldsw + _i * 8192), 16, 0, 0); } while (0)
#define PG8_LDA(dst, b, h) do { _Pragma("unroll") for (int m = 0; m < 4; ++m) _Pragma("unroll") for (int k = 0; k < 2; ++k) dst[m][k] = *(const PG8_LAS bf16x8*)(lds + PG8_SA(b, h) + aoff + m * 2048 + k * 1024); } while (0)
#define PG8_LDB(dst, b, h) do { _Pragma("unroll") for (int n = 0; n < 2; ++n) _Pragma("unroll") for (int k = 0; k < 2; ++k) dst[n][k] = *(const PG8_LAS bf16x8*)(lds + PG8_SB(b, h) + boff + n * 2048 + k * 1024); } while (0)
#define PG8_MMA(ai, bj, At, Bt) do { __builtin_amdgcn_s_setprio(1); _Pragma("unroll") for (int m = 0; m < 4; ++m) _Pragma("unroll") for (int n = 0; n < 2; ++n) _Pragma("unroll") for (int k = 0; k < 2; ++k) \
        acc[ai][bj][m][n] = __builtin_amdgcn_mfma_f32_16x16x32_bf16(Bt[n][k], At[m][k], acc[ai][bj][m][n], 0, 0, 0); __builtin_amdgcn_s_setprio(0); } while (0)
#define PG8_WAIT_V(n) asm volatile("s_waitcnt vmcnt(" #n ")" ::: "memory")
#define PG8_WAIT_L(n) asm volatile("s_waitcnt lgkmcnt(" #n ")" ::: "memory")
#define PG8_BAR __builtin_amdgcn_s_barrier()
#define PG8_SCHED __builtin_amdgcn_sched_barrier(0)
    Unit cur, nxt; int ui = 0;
    if (!S.next(0, cur)) return;
    f32x4 acc[2][2][4][2];
#pragma unroll
    for (int a = 0; a < 2; ++a)
#pragma unroll
        for (int b = 0; b < 2; ++b)
#pragma unroll
            for (int m = 0; m < 4; ++m)
#pragma unroll
                for (int n = 0; n < 2; ++n) acc[a][b][m][n] = (f32x4){0.f, 0.f, 0.f, 0.f};
    bf16x8 At[4][2], B0[2][2], B1[2][2];
    const char* cA = (const char*)g.A + (size_t)cur.pm * tstep; const char* cB = (const char*)g.Bt + (size_t)cur.pn * tstep;
    S.a_ready(cur);
    if constexpr (SP2) {
        PG8_STAGE(PG8_SB(0, 0), cB, voffB); PG8_STAGE(PG8_SB(0, 1), cB + hstep, voffB); PG8_STAGE(PG8_SA(0, 0), cA, voffA); PG8_STAGE(PG8_SA(0, 1), cA + hstep, voffA);
        if (wr == 1) PG8_BAR;
        PG8_WAIT_V(2); PG8_BAR;
        PG8_STAGE(PG8_SB(1, 0), cB + kstep, voffB); PG8_STAGE(PG8_SA(1, 0), cA + kstep, voffA); PG8_STAGE(PG8_SB(1, 1), cB + hstep + kstep, voffB);
        PG8_WAIT_V(6); PG8_BAR;
    } else {
        PG8_STAGE(PG8_SB(0, 0), cB, voffB); PG8_STAGE(PG8_SA(0, 0), cA, voffA); PG8_STAGE(PG8_SB(0, 1), cB + hstep, voffB); PG8_STAGE(PG8_SA(0, 1), cA + hstep, voffA);
        if (wr == 1) PG8_BAR;
        PG8_WAIT_V(4); PG8_BAR;
        PG8_STAGE(PG8_SB(1, 0), cB + kstep, voffB); PG8_STAGE(PG8_SA(1, 0), cA + kstep, voffA); PG8_STAGE(PG8_SB(1, 1), cB + hstep + kstep, voffB);
        PG8_WAIT_V(6); PG8_BAR;
    }
    for (;;) {
        const bool has_next = S.next(ui + 1, nxt);
        const char* nA = has_next ? (const char*)g.A + (size_t)nxt.pm * tstep : cA; const char* nB = has_next ? (const char*)g.Bt + (size_t)nxt.pn * tstep : cB;
        for (int t = 0; t < nt; t += 2) {
            if constexpr (MIDT > 0) { if (t == MIDT) E.mid(acc, cur, wr, wc, fr, fq); }
            const bool last = (t == nt - 2);
            const char* a1 = cA + (size_t)(t + 1) * kstep;
            const char* a2 = last ? nA : cA + (size_t)(t + 2) * kstep; const char* b2 = last ? nB : cB + (size_t)(t + 2) * kstep;
            const char* a3 = a2 + kstep; const char* b3 = b2 + kstep;
            if (last && has_next) S.a_ready(nxt);
            if constexpr (SP2) {
            PG8_LDB(B0, 0, 0); PG8_LDB(B1, 0, 1); PG8_SCHED; PG8_LDA(At, 0, 0); PG8_STAGE(PG8_SA(1, 1), a1 + hstep, voffA);
            PG8_WAIT_V(8); PG8_WAIT_L(0); PG8_BAR; PG8_MMA(0, 0, At, B0); PG8_MMA(0, 1, At, B1); PG8_BAR; PG8_SCHED;
            PG8_LDA(At, 0, 1); PG8_STAGE(PG8_SB(0, 0), b2, voffB); PG8_STAGE(PG8_SB(0, 1), b2 + hstep, voffB); PG8_STAGE(PG8_SA(0, 0), a2, voffA);
            PG8_WAIT_V(8); PG8_WAIT_L(0); PG8_BAR; PG8_MMA(1, 0, At, B0); PG8_MMA(1, 1, At, B1); PG8_BAR; PG8_SCHED;
            PG8_LDB(B0, 1, 0); PG8_LDB(B1, 1, 1); PG8_SCHED; PG8_LDA(At, 1, 0); PG8_STAGE(PG8_SA(0, 1), a2 + hstep, voffA);
            PG8_WAIT_V(8); PG8_WAIT_L(0); PG8_BAR; PG8_MMA(0, 0, At, B0); PG8_MMA(0, 1, At, B1); PG8_BAR; PG8_SCHED;
            PG8_LDA(At, 1, 1); PG8_STAGE(PG8_SB(1, 0), b3, voffB); PG8_STAGE(PG8_SB(1, 1), b3 + hstep, voffB); PG8_STAGE(PG8_SA(1, 0), a3, voffA);
            PG8_WAIT_V(8); PG8_WAIT_L(0); PG8_BAR; PG8_MMA(1, 0, At, B0); PG8_MMA(1, 1, At, B1); PG8_BAR; PG8_SCHED;
            } else {
            PG8_LDB(B0, 0, 0); PG8_SCHED; PG8_LDA(At, 0, 0); PG8_STAGE(PG8_SA(1, 1), a1 + hstep, voffA);
            PG8_WAIT_L(8); PG8_BAR; PG8_WAIT_L(0); PG8_MMA(0, 0, At, B0); PG8_BAR; PG8_SCHED;
            PG8_LDB(B1, 0, 1); PG8_STAGE(PG8_SB(0, 0), b2, voffB);
            PG8_BAR; PG8_WAIT_L(0); PG8_MMA(0, 1, At, B1); PG8_BAR;
            PG8_LDA(At, 0, 1); PG8_STAGE(PG8_SA(0, 0), a2, voffA);
            PG8_BAR; PG8_WAIT_L(0); PG8_MMA(1, 0, At, B0); PG8_BAR; PG8_SCHED;
            PG8_STAGE(PG8_SB(0, 1), b2 + hstep, voffB);
            PG8_WAIT_V(6); PG8_BAR; PG8_MMA(1, 1, At, B1); PG8_BAR;
            PG8_LDB(B0, 1, 0); PG8_SCHED; PG8_LDA(At, 1, 0); PG8_STAGE(PG8_SA(0, 1), a2 + hstep, voffA);
            PG8_WAIT_L(8); PG8_BAR; PG8_WAIT_L(0); PG8_MMA(0, 0, At, B0); PG8_BAR; PG8_SCHED;
            PG8_LDB(B1, 1, 1); PG8_STAGE(PG8_SB(1, 0), b3, voffB);
            PG8_BAR; PG8_WAIT_L(0); PG8_MMA(0, 1, At, B1); PG8_BAR;
            PG8_LDA(At, 1, 1); PG8_STAGE(PG8_SA(1, 0), a3, voffA);
            PG8_BAR; PG8_WAIT_L(0); PG8_MMA(1, 0, At, B0); PG8_BAR; PG8_SCHED;
            PG8_STAGE(PG8_SB(1, 1), b3 + hstep, voffB);
            PG8_WAIT_V(6); PG8_BAR; PG8_MMA(1, 1, At, B1); PG8_BAR;
            }
        }
        if constexpr (ALIGN_EPI) { if (wr == 0) PG8_BAR; }
        E(acc, cur, wr, wc, fr, fq); S.done(cur);
        if (!has_next) break;
#pragma unroll
        for (int a = 0; a < 2; ++a)
#pragma unroll
            for (int b = 0; b < 2; ++b)
#pragma unroll
                for (int m = 0; m < 4; ++m)
#pragma unroll
                    for (int n = 0; n < 2; ++n) acc[a][b][m][n] = (f32x4){0.f, 0.f, 0.f, 0.f};
        cur = nxt; cA = nA; cB = nB; ++ui;
        if constexpr (ALIGN_EPI) { if (wr == 1) PG8_BAR; }
    }
    PG8_WAIT_V(0);
    if constexpr (!ALIGN_EPI) { if (wr == 0) PG8_BAR; }
    PG8_BAR;
#undef PG8_SA
#undef PG8_SB
#undef PG8_STAGE
#undef PG8_LDA
#undef PG8_LDB
#undef PG8_MMA
#undef PG8_WAIT_V
#undef PG8_WAIT_L
#undef PG8_BAR
#undef PG8_SCHED
}
}

#ifndef PG8_SP2
#define PG8_SP2 true
#endif
#ifndef PG8_ALIGN
#define PG8_ALIGN true
#endif

constexpr int NWAVES = 8;
constexpr int N_PHASES = 10;
#ifndef MK_ONE_LAUNCH
#define MK_ONE_LAUNCH 1
#endif

constexpr size_t MiB = 1u << 20;
constexpr size_t WS_CTL = 0, CTL_ZERO_BYTES = 1 * MiB;
constexpr size_t WS_W1 = 2 * MiB;
constexpr size_t WS_W2 = 11 * MiB;
constexpr size_t WS_W3 = 13 * MiB;
constexpr size_t WS_W4 = 15 * MiB;
constexpr size_t WS_W5 = 26 * MiB;
constexpr size_t WS_IG = 32 * MiB;
constexpr size_t WS_LF = 32 * MiB + 512 * 1024;
constexpr size_t WS_H = 33 * MiB;
constexpr size_t WS_Z = 66 * MiB;
constexpr size_t WS_R = 140 * MiB;
constexpr size_t WS_SMG = 173 * MiB;
constexpr size_t WS_Y = 206 * MiB;
constexpr size_t WS_MIX = WS_Z;
constexpr size_t WS_ACT = WS_Z;
constexpr size_t WS_END = 256 * MiB;
static_assert(WS_W1 + (size_t)NG1 * DM * 2 <= WS_W2 && WS_W4 + (size_t)NFF2 * DM * 2 <= WS_W5 && WS_W5 + (size_t)DM * DFF * 2 <= WS_IG, "ws map 1");
static_assert(WS_H + (size_t)MPAD * DM * 2 <= WS_Z && WS_Z + (size_t)MPAD * NZ * 2 <= WS_R && WS_R + (size_t)MPAD * DM * 2 <= WS_SMG && WS_SMG + (size_t)MPAD * DM * 2 <= WS_Y && WS_Y + (size_t)MPAD * DM * 2 <= WS_END, "ws map 2");
static_assert(WS_ACT + (size_t)MPAD * DFF * 2 <= WS_SMG && (size_t)NROWS * 512 * 4 <= (size_t)MPAD * DM * 2, "ws map 3");
constexpr int CW_BAR = 4096;

constexpr int RING_OFF = 0, RING_BYTES = 131072;
constexpr int LDSCTL_OFF = RING_BYTES, MISC_OFF = LDSCTL_OFF + 320;
constexpr int LDS_BYTES = 147456;

#define GAS __attribute__((address_space(1)))
#define LAS __attribute__((address_space(3)))
typedef unsigned short bf16;
typedef unsigned v4u __attribute__((ext_vector_type(4)));
typedef unsigned v2u __attribute__((ext_vector_type(2)));
typedef float f32x4 __attribute__((ext_vector_type(4)));
typedef GAS unsigned gu32;
#define RLX_AGENT __ATOMIC_RELAXED, __HIP_MEMORY_SCOPE_AGENT
#define LDS_WAIT() asm volatile("s_waitcnt lgkmcnt(0)" ::: "memory")
#define VM_WAIT() asm volatile("s_waitcnt vmcnt(0)" ::: "memory")
__device__ __forceinline__ unsigned f2bf(float f) { unsigned u = __builtin_bit_cast(unsigned, f); return (u + 0x7fffu + ((u >> 16) & 1u)) >> 16; }
__device__ __forceinline__ unsigned pk2(float lo, float hi) { return f2bf(lo) | (f2bf(hi) << 16); }
__device__ __forceinline__ float bf2f(unsigned short b) { return __uint_as_float((unsigned)b << 16); }

#define XB_TMO      128
#define XB_XCNT(j)  (256  + 64 * (j))
#define XB_XSUB(j)  (1280 + 64 * (j))
#define XB_XGEN(j)  (2304 + 64 * (j))
#define XB_TOP      3328
#define XB_TOPGEN   3392
#define XCD_BAR_WORDS 3456
#define XB_SPIN_CAP (1u << 18)
__device__ __forceinline__ unsigned xb_ld(unsigned* p)              { return __hip_atomic_load(p, __ATOMIC_RELAXED, __HIP_MEMORY_SCOPE_AGENT); }
__device__ __forceinline__ unsigned xb_add(unsigned* p, unsigned v) { return __hip_atomic_fetch_add(p, v, __ATOMIC_RELAXED, __HIP_MEMORY_SCOPE_AGENT); }
__device__ __forceinline__ unsigned xb_xcc_id() { return (unsigned)__builtin_amdgcn_s_getreg((3 << 11) | 20) & 0xFu; }
#define XB_SPIN(cond, bar) do { unsigned _sp = 0; while (cond) { __builtin_amdgcn_s_sleep(1); \
    if ((++_sp & 255u) == 0u) { if (xb_ld(&(bar)[XB_TMO])) break; if (_sp > XB_SPIN_CAP) { atomicAdd(&(bar)[XB_TMO], 1u); break; } } } } while (0)
struct XcdBarrier { unsigned* bar; unsigned x; volatile LAS unsigned* st; };
__device__ __forceinline__ XcdBarrier xcd_barrier_post(unsigned* bar, volatile LAS unsigned* st) {
    XcdBarrier b; b.bar = bar; b.x = xb_xcc_id(); b.st = st;
    if (threadIdx.x == 0) (void)xb_add(&bar[XB_XCNT(b.x)], 1u);
    return b;
}
__device__ __forceinline__ void xcd_barrier_complete(unsigned* bar, unsigned x, unsigned& nloc, unsigned& nx) {
    const unsigned G = gridDim.x * gridDim.y * gridDim.z;
    unsigned sum, cnt, mine, sp = 0u;
    for (;;) {
        sum = 0u; cnt = 0u; mine = 0u;
#pragma unroll
        for (unsigned j = 0; j < 16; ++j) { const unsigned c = xb_ld(&bar[XB_XCNT(j)]); sum += c; cnt += (c > 0u) ? 1u : 0u; mine = (j == x) ? c : mine; }
        if (sum == G) break;
        __builtin_amdgcn_s_sleep(1);
        if ((++sp & 255u) == 0u) { if (xb_ld(&bar[XB_TMO])) break; if (sp > XB_SPIN_CAP) { atomicAdd(&bar[XB_TMO], 1u); break; } }
    }
    nloc = mine > 0u ? mine : 1u; nx = cnt > 0u ? cnt : 1u;
}
__device__ __forceinline__ void xcd_barrier(const XcdBarrier& b) {
    asm volatile("s_waitcnt vmcnt(0)" ::: "memory");
    __syncthreads();
    if (threadIdx.x == 0) {
        unsigned* bar = b.bar;
        __builtin_amdgcn_s_waitcnt(0);
        unsigned nloc = b.st[0], nx = b.st[1];
        if (nloc == 0u) { xcd_barrier_complete(bar, b.x, nloc, nx); b.st[0] = nloc; b.st[1] = nx; }
        const unsigned old = xb_add(&bar[XB_XSUB(b.x)], 1u);
        const unsigned gen = old / nloc;
        if (old + 1u == (gen + 1u) * nloc) {
            __builtin_amdgcn_fence(__ATOMIC_RELEASE, "agent");
            asm volatile("s_waitcnt vmcnt(0)" ::: "memory");
            const unsigned og = xb_add(&bar[XB_TOP], 1u);
            const unsigned tg = og / nx;
            if (og + 1u == (tg + 1u) * nx) xb_add(&bar[XB_TOPGEN], 1u);
            else XB_SPIN(xb_ld(&bar[XB_TOPGEN]) == tg, bar);
            __builtin_amdgcn_fence(__ATOMIC_ACQUIRE, "agent");
            xb_add(&bar[XB_XGEN(b.x)], 1u);
            asm volatile("s_waitcnt vmcnt(0)" ::: "memory");
        } else {
            XB_SPIN(xb_ld(&bar[XB_XGEN(b.x)]) == gen, bar);
            __builtin_amdgcn_fence(__ATOMIC_ACQUIRE, "agent");
            asm volatile("s_waitcnt vmcnt(0)" ::: "memory");
        }
    }
    __syncthreads();
}

struct Args { const float* in[21]; float* out; unsigned char* ws; int ph_lo, ph_hi, li, pad; };
struct Frame {
    LAS unsigned char* lds;
    volatile LAS unsigned* MISC;
    int wave;
    int vcu, G;
    const Args* a;
};
__device__ __forceinline__ int lane_id_fresh() { int l; asm volatile("v_mbcnt_lo_u32_b32 %0, -1, 0\n\tv_mbcnt_hi_u32_b32 %0, -1, %0" : "=v"(l)); return l; }
#define A_IN(i) (F.a->in[i])
#define xp_ A_IN(0)
#define xs_ A_IN(1)
#define cache_k_ A_IN(2)
#define cache_v_ A_IN(3)
#define stC_ A_IN(4)
#define stN_ A_IN(5)
#define stM_ A_IN(6)
#define rel_bias_ A_IN(7)
#define w_in_ A_IN(8)
#define b_if_ A_IN(9)
#define sinks_ A_IN(10)
#define g_attn_ A_IN(11)
#define g_head_ A_IN(12)
#define w_att_out_ A_IN(13)
#define w_mlstm_out_ A_IN(14)
#define w_out_ A_IN(15)
#define g_ffn_ A_IN(16)
#define w_gate_ A_IN(17)
#define w_up_ A_IN(18)
#define w_down_ A_IN(19)
#define g_final_ A_IN(20)
#define out_ (F.a->out)
#define WSP(T, off) ((T*)(F.a->ws + (off)))
#define W1_ WSP(bf16, WS_W1)
#define W2_ WSP(bf16, WS_W2)
#define W3_ WSP(bf16, WS_W3)
#define W4_ WSP(bf16, WS_W4)
#define W5_ WSP(bf16, WS_W5)
#define H_ WSP(bf16, WS_H)
#define Z_ WSP(bf16, WS_Z)
#define R_ WSP(bf16, WS_R)
#define SMG_ WSP(bf16, WS_SMG)
#define Y_ WSP(bf16, WS_Y)
#define MIX_ WSP(bf16, WS_MIX)
#define ACT_ WSP(bf16, WS_ACT)
#define IG_ WSP(float, WS_IG)
#define LF_ WSP(float, WS_LF)
#define HRAW_ WSP(float, WS_H)

__device__ __forceinline__ float wave_sum(float v) {
#pragma unroll
    for (int o = 1; o < 64; o <<= 1) v += __shfl_xor(v, o);
    return v;
}

__device__ __forceinline__ void tr_item(const float* W, int ldw, int k0, int n0, bf16* WT, int ldt, int r0, int c0, LAS float* scr, int lane) {
#pragma unroll 8
    for (int i = 0; i < 32; ++i) { const int kk = 2 * i + (lane >> 5); scr[kk * 33 + (lane & 31)] = W[(size_t)(k0 + kk) * ldw + n0 + (lane & 31)]; }
    LDS_WAIT(); asm volatile("" ::: "memory");
    const int c = lane & 7;
#pragma unroll
    for (int j = 0; j < 4; ++j) { const int n = (lane >> 3) + 8 * j; const LAS float* s = scr + (8 * c) * 33 + n;
        v4u o; o.x = pk2(s[0 * 33], s[1 * 33]); o.y = pk2(s[2 * 33], s[3 * 33]); o.z = pk2(s[4 * 33], s[5 * 33]); o.w = pk2(s[6 * 33], s[7 * 33]);
        *(GAS v4u*)(WT + (size_t)(r0 + n) * ldt + c0 + 8 * c) = o; }
    LDS_WAIT(); asm volatile("" ::: "memory");
}
__device__ __forceinline__ float log_sigmoid(float x) { return fminf(x, 0.f) - log1pf(__expf(-fabsf(x))); }

__device__ __forceinline__ void p0_prologue(Frame& F) {
    const int LN_ = lane_id_fresh(); const int TID_ = F.wave * 64 + LN_; (void)TID_;
    LAS float* scr = (LAS float*)(F.lds + RING_OFF + F.wave * 16384);
    const int gw = F.vcu * NWAVES + F.wave, NGW = F.G * NWAVES;
    constexpr int I1 = 16 * (NG1 / 32), I2 = 16 * 32, I3 = 16 * 32, I4 = 16 * (NFF2 / 32), I5 = (DFF / 64) * 32;
    constexpr int NITEMS = I1 + I2 + I3 + I4 + I5;
    for (int it = gw; it < NITEMS; it += NGW) {
        int r = it;
        if (r < I1) { const int kb = r / (NG1 / 32), nb = r % (NG1 / 32), d = 32 * nb; int n0;
            if (d < NZ) n0 = d; else { const int t = (d - NZ) / 256, j = (d - NZ) % 256; n0 = (j < 128) ? (WC_GA + t * 128 + j) : (WC_GM + t * 128 + j - 128); }
            tr_item(w_in_, NIN, 64 * kb, n0, W1_, DM, d, 64 * kb, scr, LN_); continue; } r -= I1;
        if (r < I2) { const int kb = r / 32, nb = r % 32;
            if (kb < 8) tr_item(w_att_out_, DM, 64 * kb, 32 * nb, W2_, DM, 32 * nb, 64 * kb, scr, LN_);
            else tr_item(w_mlstm_out_, DM, 64 * (kb - 8), 32 * nb, W2_, DM, 32 * nb, 64 * kb, scr, LN_);
            continue; } r -= I2;
        if (r < I3) { const int kb = r / 32, nb = r % 32; tr_item(w_out_, DM, 64 * kb, 32 * nb, W3_, DM, 32 * nb, 64 * kb, scr, LN_); continue; } r -= I3;
        if (r < I4) { const int kb = r / (NFF2 / 32), rb = r % (NFF2 / 32), d = 32 * rb, t = d / 256, j = d % 256;
            if (j < 128) tr_item(w_gate_, DFF, 64 * kb, t * 128 + j, W4_, DM, d, 64 * kb, scr, LN_);
            else tr_item(w_up_, DFF, 64 * kb, t * 128 + j - 128, W4_, DM, d, 64 * kb, scr, LN_);
            continue; } r -= I4;
        { const int kb = r / 32, nb = r % 32; tr_item(w_down_, DM, 64 * kb, 32 * nb, W5_, DFF, 32 * nb, 64 * kb, scr, LN_); }
    }
    __syncthreads();
    LAS float* wif = (LAS float*)(F.lds + RING_OFF);
    for (int i = TID_; i < 8 * DM; i += NWAVES * 64) { const int g = i >> 10, k = i & (DM - 1); wif[i] = w_in_[(size_t)k * NIN + WC_IF + g] * g_attn_[k]; }
    __syncthreads();
    const LAS f32x4* wif4 = (const LAS f32x4*)wif;
    for (int row = gw; row < NROWS; row += NGW) {
        const float* xrow = row < NTOK_P ? xp_ + (size_t)row * DM : xs_ + (size_t)(row - NTOK_P) * DM;
        const GAS f32x4* xr = (const GAS f32x4*)xrow + LN_;
        f32x4 v[4]; float ss = 0.f; float gd[8];
#pragma unroll
        for (int g = 0; g < 8; ++g) gd[g] = 0.f;
#pragma unroll
        for (int j = 0; j < 4; ++j) { v[j] = xr[64 * j]; ss += (v[j].x * v[j].x + v[j].y * v[j].y) + (v[j].z * v[j].z + v[j].w * v[j].w); }
#pragma unroll
        for (int j = 0; j < 4; ++j)
#pragma unroll
            for (int g = 0; g < 8; ++g) { const f32x4 w = wif4[g * 256 + 64 * j + LN_]; gd[g] += (v[j].x * w.x + v[j].y * w.y) + (v[j].z * w.z + v[j].w * w.w); }
        ss = wave_sum(ss);
#pragma unroll
        for (int g = 0; g < 8; ++g) gd[g] = wave_sum(gd[g]);
        const float rstd = 1.0f / sqrtf(ss * (1.0f / DM) + EPS);
        GAS unsigned long long* o8 = (GAS unsigned long long*)(H_ + (size_t)row * DM) + LN_;
#pragma unroll
        for (int j = 0; j < 4; ++j) { const f32x4 gg = *((const GAS f32x4*)g_attn_ + 64 * j + LN_);
            o8[64 * j] = (unsigned long long)pk2(v[j].x * rstd * gg.x, v[j].y * rstd * gg.y) | ((unsigned long long)pk2(v[j].z * rstd * gg.z, v[j].w * rstd * gg.w) << 32); }
        if (LN_ == 0) {
            f32x4 ig, lf;
            ig.x = gd[0] * rstd + b_if_[0]; ig.y = gd[1] * rstd + b_if_[1]; ig.z = gd[2] * rstd + b_if_[2]; ig.w = gd[3] * rstd + b_if_[3];
            lf.x = log_sigmoid(gd[4] * rstd + b_if_[4]); lf.y = log_sigmoid(gd[5] * rstd + b_if_[5]); lf.z = log_sigmoid(gd[6] * rstd + b_if_[6]); lf.w = log_sigmoid(gd[7] * rstd + b_if_[7]);
            *(f32x4*)(IG_ + (size_t)row * 4) = ig; *(f32x4*)(LF_ + (size_t)row * 4) = lf;
        }
    }
    { const int gt = F.vcu * (NWAVES * 64) + TID_, NGT = F.G * NWAVES * 64; constexpr int NPAD16 = (MPAD - NROWS) * DM * 2 / 16;
      GAS v4u* hp = (GAS v4u*)(H_ + (size_t)NROWS * DM);
      for (int i = gt; i < NPAD16; i += NGT) hp[i] = (v4u){0u, 0u, 0u, 0u};
      constexpr int PERB = 127 * 128 / 4;
      for (int i = gt; i < NSAMP * PERB; i += NGT) { const int b = i / PERB, o = i % PERB;
          const f32x4 kk = *((const GAS f32x4*)(cache_k_ + (size_t)b * 16384 + 128) + o); const f32x4 vv = *((const GAS f32x4*)(cache_v_ + (size_t)b * 16384 + 128) + o);
          *((GAS f32x4*)(out_ + OFF_SK + (size_t)b * 16384) + o) = kk; *((GAS f32x4*)(out_ + OFF_SV + (size_t)b * 16384) + o) = vv; }
    }
}

__device__ __forceinline__ int t5_bucket(int n) {
    if (n < 16) return n;
    const float v = logf((float)n * (1.0f / 16.0f)) / 2.0794415416798357f * 16.0f;
    const int l = 16 + (int)v; return l < 31 ? l : 31;
}
__device__ __forceinline__ void mlstm_chain(Frame& F, const int LN_, int r0, int S, int h, int vs, const float* C0, const float* n0, const float* m0, float* Cout, float* nout, float* mout) {
    const int lane = LN_;
    float C[8], nn, m;
#pragma unroll
    for (int i = 0; i < 8; ++i) C[i] = C0 ? C0[(size_t)(vs * 8 + i) * 64 + lane] : 0.f;
    nn = n0 ? n0[lane] : 0.f; m = m0 ? m0[0] : 0.f;
    for (int t = 0; t < S; ++t) {
        const size_t row = (size_t)(r0 + t);
        const bf16* zr = Z_ + row * NZ;
        const float q = bf2f(zr[ZC_QM + h * 64 + lane]), k = bf2f(zr[ZC_KM + h * 64 + lane]) * 0.125f;
        const v4u vraw = *(const v4u*)(zr + ZC_VM + h * 128 + vs * 8);
        const float ig = IG_[row * 4 + h], lf = LF_[row * 4 + h];
        float vv[8]; vv[0] = pg8::bf_lo(vraw.x); vv[1] = pg8::bf_hi(vraw.x); vv[2] = pg8::bf_lo(vraw.y); vv[3] = pg8::bf_hi(vraw.y); vv[4] = pg8::bf_lo(vraw.z); vv[5] = pg8::bf_hi(vraw.z); vv[6] = pg8::bf_lo(vraw.w); vv[7] = pg8::bf_hi(vraw.w);
        const float mn = fmaxf(lf + m, ig), fd = __expf(lf + m - mn), iw = __expf(ig - mn);
        float num[8];
#pragma unroll
        for (int i = 0; i < 8; ++i) { C[i] = fd * C[i] + iw * vv[i] * k; num[i] = wave_sum(C[i] * q); }
        nn = fd * nn + iw * k; m = mn;
        const float den = fmaxf(fabsf(wave_sum(nn * q)), __expf(-mn));
        float o = num[0];
#pragma unroll
        for (int i = 1; i < 8; ++i) o = (lane == i) ? num[i] : o;
        if (lane < 8) HRAW_[row * 512 + h * 128 + vs * 8 + lane] = o / den;
    }
#pragma unroll
    for (int i = 0; i < 8; ++i) Cout[(size_t)(vs * 8 + i) * 64 + lane] = C[i];
    if (vs == 0) { nout[lane] = nn; if (lane == 0) mout[0] = m; }
}
__device__ __forceinline__ void attn_item_prompt(Frame& F, const int LN_, int row, int hq) {
    const int lane = LN_, b = row >> 13, t = row & (SEQ - 1), kvh = hq >> 2;
    const float q = bf2f(Z_[(size_t)row * NZ + ZC_QA + hq * 64 + lane]) * 0.125f;
    float m = sinks_[hq], l = 1.0f, acc = 0.f;
    const int j0 = t - 127 < 0 ? 0 : t - 127;
    for (int j = j0; j <= t; ++j) {
        const bf16* zr = Z_ + (size_t)(b * SEQ + j) * NZ;
        const float kd = bf2f(zr[ZC_KA + kvh * 64 + lane]), vd = bf2f(zr[ZC_VA + kvh * 64 + lane]);
        const float s = wave_sum(q * kd) + rel_bias_[t5_bucket(t - j) * 8 + hq];
        const float mn = fmaxf(m, s), al = __expf(m - mn), p = __expf(s - mn);
        l = l * al + p; acc = acc * al + p * vd; m = mn;
    }
    Y_[(size_t)row * DM + hq * 64 + lane] = (bf16)f2bf(acc / l);
}
__device__ __forceinline__ void attn_item_sample(Frame& F, const int LN_, int b, int hq) {
    const int lane = LN_, kvh = hq >> 2; const size_t row = (size_t)(NTOK_P + b);
    const float q = bf2f(Z_[row * NZ + ZC_QA + hq * 64 + lane]) * 0.125f;
    float m = sinks_[hq], l = 1.0f, acc = 0.f;
    for (int j = 1; j <= 128; ++j) {
        float kd, vd;
        if (j < 128) { kd = cache_k_[((size_t)(b * 128 + j) * 2 + kvh) * 64 + lane]; vd = cache_v_[((size_t)(b * 128 + j) * 2 + kvh) * 64 + lane]; }
        else { kd = bf2f(Z_[row * NZ + ZC_KA + kvh * 64 + lane]); vd = bf2f(Z_[row * NZ + ZC_VA + kvh * 64 + lane]); }
        const float s = wave_sum(q * kd) + rel_bias_[t5_bucket(128 - j) * 8 + hq];
        const float mn = fmaxf(m, s), al = __expf(m - mn), p = __expf(s - mn);
        l = l * al + p; acc = acc * al + p * vd; m = mn;
    }
    Y_[row * DM + hq * 64 + lane] = (bf16)f2bf(acc / l);
}
__device__ __forceinline__ void p2_simple(Frame& F) {
    const int LN_ = lane_id_fresh(); const int TID_ = F.wave * 64 + LN_; (void)TID_;
    const int gw = F.wave * F.G + (int)blockIdx.x, NGW = F.G * NWAVES;
    constexpr int I_PC = 2 * 4 * 16, I_SC = NSAMP * 4 * 16, I_AP = NTOK_P * 8, I_AS = NSAMP * 8;
    for (int it = gw; it < I_PC + I_SC + I_AP + I_AS; it += NGW) {
        int r = it;
        if (r < I_PC) { const int vs = r & 15, h = (r >> 4) & 3, b = r >> 6;
            mlstm_chain(F, LN_, b * SEQ, SEQ, h, vs, nullptr, nullptr, nullptr, out_ + OFF_PC + (size_t)(b * 4 + h) * 8192, out_ + OFF_PN + (size_t)(b * 4 + h) * 64, out_ + OFF_PM + (b * 4 + h)); continue; } r -= I_PC;
        if (r < I_SC) { const int vs = r & 15, h = (r >> 4) & 3, b = r >> 6;
            mlstm_chain(F, LN_, NTOK_P + b, 1, h, vs, stC_ + (size_t)(b * 4 + h) * 8192, stN_ + (size_t)(b * 4 + h) * 64, stM_ + (b * 4 + h),
                        out_ + OFF_SC + (size_t)(b * 4 + h) * 8192, out_ + OFF_SN + (size_t)(b * 4 + h) * 64, out_ + OFF_SM + (b * 4 + h)); continue; } r -= I_SC;
        if (r < I_AP) { attn_item_prompt(F, LN_, r >> 3, r & 7); continue; } r -= I_AP;
        attn_item_sample(F, LN_, r >> 3, r & 7);
    }
}
__device__ __forceinline__ void p3_hnorm(Frame& F) {
    const int LN_ = lane_id_fresh(); const int TID_ = F.wave * 64 + LN_; (void)TID_;
    const int gw = F.vcu * NWAVES + F.wave, NGW = F.G * NWAVES, lane = LN_;
    for (int it = gw; it < NROWS * 4; it += NGW) { const int row = it >> 2, h = it & 3;
        const float a = HRAW_[(size_t)row * 512 + h * 128 + 2 * lane], b = HRAW_[(size_t)row * 512 + h * 128 + 2 * lane + 1];
        const float ss = wave_sum(a * a + b * b), rs = 1.0f / sqrtf(ss * (1.0f / 128.0f) + EPS);
        const unsigned ow = *(const unsigned*)(Z_ + (size_t)row * NZ + ZC_OM + h * 128 + 2 * lane);
        const float ya = a * rs * g_head_[h * 128 + 2 * lane] * pg8::sigmoidf_(pg8::bf_lo(ow)), yb = b * rs * g_head_[h * 128 + 2 * lane + 1] * pg8::sigmoidf_(pg8::bf_hi(ow));
        *(unsigned*)(Y_ + (size_t)row * DM + 512 + h * 128 + 2 * lane) = pk2(ya, yb); }
}
__device__ __forceinline__ void p6_norm_to_h(Frame& F) {
    const int LN_ = lane_id_fresh(); const int TID_ = F.wave * 64 + LN_; (void)TID_;
    const int gw = F.vcu * NWAVES + F.wave, NGW = F.G * NWAVES;
    for (int row = gw; row < NROWS; row += NGW) {
        const GAS f32x4* xr = (const GAS f32x4*)(out_ + OFF_Y + (size_t)row * DM) + LN_;
        f32x4 v[4]; float ss = 0.f;
#pragma unroll
        for (int j = 0; j < 4; ++j) { v[j] = xr[64 * j]; ss += (v[j].x * v[j].x + v[j].y * v[j].y) + (v[j].z * v[j].z + v[j].w * v[j].w); }
        ss = wave_sum(ss); const float rstd = 1.0f / sqrtf(ss * (1.0f / DM) + EPS);
        GAS unsigned long long* o8 = (GAS unsigned long long*)(H_ + (size_t)row * DM) + LN_;
#pragma unroll
        for (int j = 0; j < 4; ++j) { const f32x4 gg = *((const GAS f32x4*)g_ffn_ + 64 * j + LN_);
            o8[64 * j] = (unsigned long long)pk2(v[j].x * rstd * gg.x, v[j].y * rstd * gg.y) | ((unsigned long long)pk2(v[j].z * rstd * gg.z, v[j].w * rstd * gg.w) << 32); }
    }
}
__device__ __forceinline__ void p9_final_norm(Frame& F) {
    const int LN_ = lane_id_fresh(); const int TID_ = F.wave * 64 + LN_; (void)TID_;
    const int gw = F.vcu * NWAVES + F.wave, NGW = F.G * NWAVES;
    for (int row = gw; row < NROWS; row += NGW) {
        GAS f32x4* xr = (GAS f32x4*)(out_ + OFF_Y + (size_t)row * DM) + LN_;
        f32x4 v[4]; float ss = 0.f;
#pragma unroll
        for (int j = 0; j < 4; ++j) { v[j] = xr[64 * j]; ss += (v[j].x * v[j].x + v[j].y * v[j].y) + (v[j].z * v[j].z + v[j].w * v[j].w); }
        ss = wave_sum(ss); const float rstd = 1.0f / sqrtf(ss * (1.0f / DM) + EPS);
#pragma unroll
        for (int j = 0; j < 4; ++j) { const f32x4 gg = *((const GAS f32x4*)g_final_ + 64 * j + LN_); xr[64 * j] = v[j] * rstd * gg; }
    }
}

__global__ void __launch_bounds__(NWAVES * 64, 2) skel_fwd(Args args) {
    extern __shared__ __attribute__((aligned(16))) unsigned char lds[];
    Frame F;
    F.lds = (LAS unsigned char*)lds;
    F.MISC = (volatile LAS unsigned*)(F.lds + MISC_OFF);
    F.wave = __builtin_amdgcn_readfirstlane((int)threadIdx.x >> 6);
    F.G = gridDim.x; { const int bx = blockIdx.x; F.vcu = (F.G % 8 == 0) ? (bx % 8) * (F.G / 8) + bx / 8 : bx; }
    F.a = &args;
    gu32* ctl = (gu32*)(args.ws + WS_CTL);
    for (int u = (int)threadIdx.x; u < (LDS_BYTES - LDSCTL_OFF) / 4; u += NWAVES * 64) ((LAS unsigned*)(F.lds + LDSCTL_OFF))[u] = 0u;
    __syncthreads();
    const int lo = args.ph_lo, hi = args.ph_hi;
    const bool multi = (hi - lo) > 1;
    XcdBarrier bar; bar.bar = (unsigned*)(ctl + CW_BAR); bar.x = 0; bar.st = nullptr;
    if (multi) bar = xcd_barrier_post((unsigned*)(ctl + CW_BAR), F.MISC + 8);
#ifndef PH_MASK
#define PH_MASK 0x3ff
#endif
#define IN(k) (((PH_MASK >> (k)) & 1) && lo <= (k) && (k) < hi)
#define SEAM(k) do { if (IN(k) && IN((k) + 1)) xcd_barrier(bar); } while (0)

    if (IN(0)) { p0_prologue(F); SEAM(0); }
    if (IN(1)) {
        pg8::Gemm g{H_, W1_, MPAD, NG1, DM}; pg8::StaticOrder S; S.init(MPAD, NG1, F.G, (int)blockIdx.x);
        pg8::EpiIn E{Z_, R_, SMG_, out_};
        pg8::gemm_phase<pg8::EpiIn, pg8::StaticOrder, PG8_ALIGN, PG8_SP2, 0>(F.lds + RING_OFF, g, S, E, F.wave, lane_id_fresh());
        SEAM(1);
    }
    if (IN(2)) { p2_simple(F); SEAM(2); }
    if (IN(3)) { p3_hnorm(F); SEAM(3); }
    if (IN(4)) {
        pg8::Gemm g{Y_, W2_, MPAD, DM, DM}; pg8::StaticOrder S; S.init(MPAD, DM, F.G, (int)blockIdx.x);
        pg8::EpiMix E{R_, SMG_, MIX_};
        pg8::gemm_phase<pg8::EpiMix, pg8::StaticOrder, PG8_ALIGN, PG8_SP2, 8>(F.lds + RING_OFF, g, S, E, F.wave, lane_id_fresh());
        SEAM(4);
    }
    if (IN(5)) {
        pg8::Gemm g{MIX_, W3_, MPAD, DM, DM}; pg8::StaticOrder S; S.init(MPAD, DM, F.G, (int)blockIdx.x);
        pg8::EpiRes E{xp_, xs_, out_ + OFF_Y};
        pg8::gemm_phase<pg8::EpiRes, pg8::StaticOrder, PG8_ALIGN, PG8_SP2, 0>(F.lds + RING_OFF, g, S, E, F.wave, lane_id_fresh());
        SEAM(5);
    }
    if (IN(6)) { p6_norm_to_h(F); SEAM(6); }
    if (IN(7)) {
        pg8::Gemm g{H_, W4_, MPAD, NFF2, DM}; pg8::StaticOrder S; S.init(MPAD, NFF2, F.G, (int)blockIdx.x);
        pg8::EpiSwiglu E{ACT_};
        pg8::gemm_phase<pg8::EpiSwiglu, pg8::StaticOrder, PG8_ALIGN, PG8_SP2, 0>(F.lds + RING_OFF, g, S, E, F.wave, lane_id_fresh());
        SEAM(7);
    }
    if (IN(8)) {
        pg8::Gemm g{ACT_, W5_, MPAD, DM, DFF}; pg8::StaticOrder S; S.init(MPAD, DM, F.G, (int)blockIdx.x);
        pg8::EpiRes E{out_ + OFF_Y, out_ + OFF_Y + (size_t)NTOK_P * DM, out_ + OFF_Y};
        pg8::gemm_phase<pg8::EpiRes, pg8::StaticOrder, PG8_ALIGN, PG8_SP2, 0>(F.lds + RING_OFF, g, S, E, F.wave, lane_id_fresh());
        SEAM(8);
    }
    if (IN(9)) { p9_final_norm(F); }
#undef IN
#undef SEAM
}

extern "C" void kernel_launch(void* const* d_in, const int* in_sizes, int n_in, void* d_out, int out_size, void* d_ws, size_t ws_size, hipStream_t stream) {
    static int grid = 0;
    if (grid == 0) {
        if (n_in != 21 || out_size != (int)OUT_END || ws_size < WS_END) { fprintf(stderr, "kernel_launch: unexpected shapes: n_in %d out %d ws %zu\n", n_in, out_size, ws_size); grid = -1; return; }
        int dev = 0, cus = 0, per_cu = 0;
        if (hipGetDevice(&dev) != hipSuccess || hipDeviceGetAttribute(&cus, hipDeviceAttributeMultiprocessorCount, dev) != hipSuccess) { grid = -1; return; }
        if (hipFuncSetAttribute((const void*)skel_fwd, hipFuncAttributeMaxDynamicSharedMemorySize, LDS_BYTES) != hipSuccess) { fprintf(stderr, "kernel_launch: hipFuncSetAttribute failed\n"); grid = -1; return; }
        if (hipOccupancyMaxActiveBlocksPerMultiprocessor(&per_cu, (const void*)skel_fwd, NWAVES * 64, LDS_BYTES) != hipSuccess || per_cu < 1)
            fprintf(stderr, "kernel_launch: note: occupancy query reports %d workgroups per CU\n", per_cu);
        (void)hipGetLastError();
        grid = cus;
    }
    if (grid < 0) return;
    if (hipMemsetAsync((char*)d_ws + WS_CTL, 0, CTL_ZERO_BYTES, stream) != hipSuccess) { fprintf(stderr, "kernel_launch: memset failed\n"); return; }
    Args a{};
    for (int i = 0; i < 21; ++i) a.in[i] = (const float*)d_in[i];
    a.out = (float*)d_out; a.ws = (unsigned char*)d_ws;
#if MK_ONE_LAUNCH
    a.ph_lo = 0; a.ph_hi = N_PHASES; a.li = 0;
    hipLaunchKernelGGL(skel_fwd, dim3(grid), dim3(NWAVES * 64), LDS_BYTES, stream, a);
#else
    for (int p = 0; p < N_PHASES; ++p) { a.ph_lo = p; a.ph_hi = p + 1; a.li = p;
        hipLaunchKernelGGL(skel_fwd, dim3(grid), dim3(NWAVES * 64), LDS_BYTES, stream, a); }
#endif
}
```

```cpp
#include <hip/hip_runtime.h>
#include <cstdio>
#include <cstdint>

constexpr int DM = 1024, SEQ = 8192, NTOK_P = 16384, NSAMP = 128, NROWS = NTOK_P + NSAMP, MPAD = 16640;
constexpr int NIN = 4360, NZ = 2304, NG1 = 4352, DFF = 2816, NFF2 = 5632;
constexpr int ZC_QA = 0, ZC_KA = 512, ZC_VA = 640, ZC_QM = 768, ZC_KM = 1024, ZC_VM = 1280, ZC_OM = 1792;
constexpr int WC_IF = 2304, WC_GA = 2312, WC_GM = 3336;
constexpr float EPS = 1e-6f;
constexpr size_t OFF_Y = 0, OFF_PK = 16908288, OFF_PV = 16941056, OFF_PC = 16973824, OFF_PN = 17039360, OFF_PM = 17039872,
                 OFF_SK = 17039880, OFF_SV = 19137032, OFF_SC = 21234184, OFF_SN = 25428488, OFF_SM = 25461256, OUT_END = 25461768;

namespace pg8 {
#define PG8_LAS __attribute__((address_space(3)))
typedef unsigned short bf16_t;
typedef short bf16x8 __attribute__((ext_vector_type(8)));
typedef float f32x4 __attribute__((ext_vector_type(4)));
typedef unsigned u32x4 __attribute__((ext_vector_type(4)));
typedef unsigned u32x2 __attribute__((ext_vector_type(2)));
constexpr int BM = 256, BK = 64, HALF = 128, HTB = HALF * BK * 2, STAGE_BYTES = 8 * HTB, NXCD = 8, WGM = 8;

__host__ __device__ __forceinline__ int lds_byte(int r, int c) { const int st = (r >> 4) * 2 + (c >> 5), rr = r & 15, cc = c & 31, ob = rr * 64 + cc * 2; return st * 1024 + (ob ^ (((ob >> 9) & 1) << 5)); }
__host__ __device__ __forceinline__ void stage_rc(int b, int& R, int& C) { const int st = b / 1024, sb = b % 1024, swz = sb ^ (((sb >> 9) & 1) << 5); R = (st >> 1) * 16 + swz / 64; C = (st & 1) * 32 + (swz % 64) / 2; }
__host__ __device__ __forceinline__ int perm32(int rho) { const int n = rho >> 4, i = rho & 15; return 8 * (i >> 2) + 4 * n + (i & 3); }

struct Unit { int pm, pn; };
struct Gemm { const bf16_t* A; const bf16_t* Bt; int M, N, K; };

struct StaticOrder {
    int nM, nN, nwg, G, c;
    __host__ __device__ void init(int M, int N, int G_, int c_) { nM = M / BM; nN = N / BM; nwg = nM * nN; G = G_; c = c_; }
    __host__ __device__ bool next(int i, Unit& u) const {
        const long L = (long)i * G + c; if (L >= nwg) return false;
        int wgid = (int)L; { const int q = nwg / NXCD, r = nwg % NXCD, xcd = wgid % NXCD, off = wgid / NXCD; wgid = (xcd < r ? xcd * (q + 1) : r * (q + 1) + (xcd - r) * q) + off; }
        const int nig = WGM * nN, gid = wgid / nig, fm = gid * WGM, gsz = (nM - fm) < WGM ? (nM - fm) : WGM;
        u.pm = fm + ((wgid % nig) % gsz); u.pn = (wgid % nig) / gsz; return true;
    }
    __device__ __forceinline__ void a_ready(const Unit&) const {}
    __device__ __forceinline__ void done(const Unit&) const {}
};

__device__ __forceinline__ unsigned cvt_pk_bf16(float lo, float hi) { unsigned r; asm volatile("v_cvt_pk_bf16_f32 %0, %1, %2" : "=v"(r) : "v"(lo), "v"(hi)); return r; }
__device__ __forceinline__ float bf_lo(unsigned w) { return __uint_as_float(w << 16); }
__device__ __forceinline__ float bf_hi(unsigned w) { return __uint_as_float(w & 0xffff0000u); }
__device__ __forceinline__ float sigmoidf_(float x) { return 1.0f / (1.0f + __expf(-x)); }


struct EpiIn {
    static constexpr bool PERM = false, AFTER_DRAIN = false;
    bf16_t* Z; bf16_t* Rb; bf16_t* SMb; float* out;
    __device__ __forceinline__ void mid(f32x4 (&)[2][2][4][2], const Unit&, int, int, int, int) const {}
    __device__ __forceinline__ void operator()(const f32x4 (&acc)[2][2][4][2], const Unit& u, int wr, int wc, int fr, int fq) const {
        const int row0 = u.pm * BM + wr * 64 + fr;
        if (u.pn < 9) {
            const int col0 = u.pn * BM + wc * 32 + 4 * fq;
#pragma unroll
            for (int ai = 0; ai < 2; ++ai)
#pragma unroll
                for (int m = 0; m < 4; ++m) { const int row = row0 + ai * HALF + m * 16; bf16_t* rowp = Z + (size_t)row * NZ + col0;
#pragma unroll
                    for (int bj = 0; bj < 2; ++bj)
#pragma unroll
                        for (int n = 0; n < 2; ++n) { const f32x4 v = acc[ai][bj][m][n]; u32x2 w; w.x = cvt_pk_bf16(v[0], v[1]); w.y = cvt_pk_bf16(v[2], v[3]);
                            *(u32x2*)(rowp + bj * HALF + n * 16) = w; } }
            if (u.pn == 2) {
#pragma unroll
                for (int ai = 0; ai < 2; ++ai)
#pragma unroll
                    for (int m = 0; m < 4; ++m) { const int row = row0 + ai * HALF + m * 16;
                        float* kp = nullptr; float* vp = nullptr;
                        if (row < NTOK_P) { const int b = row >> 13, t = row & (SEQ - 1); if (t >= SEQ - 128) { const size_t o = ((size_t)(b * 128 + (t - (SEQ - 128)))) * 128; kp = out + OFF_PK + o; vp = out + OFF_PV + o; } }
                        else if (row < NROWS) { const size_t o = ((size_t)((row - NTOK_P) * 128 + 127)) * 128; kp = out + OFF_SK + o; vp = out + OFF_SV + o; }
                        if (kp) {
#pragma unroll
                            for (int n = 0; n < 2; ++n) { const int c = wc * 32 + n * 16 + 4 * fq; *(f32x4*)(kp + c) = acc[ai][0][m][n]; *(f32x4*)(vp + c) = acc[ai][1][m][n]; } } }
            }
        } else {
            const int ch0 = (u.pn - 9) * 128 + wc * 32 + 4 * fq;
#pragma unroll
            for (int ai = 0; ai < 2; ++ai)
#pragma unroll
                for (int m = 0; m < 4; ++m) { const int row = row0 + ai * HALF + m * 16;
#pragma unroll
                    for (int n = 0; n < 2; ++n) { const f32x4 ga = acc[ai][0][m][n], gm = acc[ai][1][m][n]; float r[4], s[4];
#pragma unroll
                        for (int e = 0; e < 4; ++e) { const float ea = __expf(-ga[e]), em = __expf(-gm[e]); s[e] = 1.0f / (1.0f + em); r[e] = (1.0f + em) / (1.0f + ea); }
                        u32x2 wr_, ws_; wr_.x = cvt_pk_bf16(r[0], r[1]); wr_.y = cvt_pk_bf16(r[2], r[3]); ws_.x = cvt_pk_bf16(s[0], s[1]); ws_.y = cvt_pk_bf16(s[2], s[3]);
                        const size_t o = (size_t)row * DM + ch0 + n * 16; *(u32x2*)(Rb + o) = wr_; *(u32x2*)(SMb + o) = ws_; } }
        }
    }
};
struct EpiMix {
    static constexpr bool PERM = false, AFTER_DRAIN = false;
    const bf16_t* Rb; const bf16_t* SMb; bf16_t* MIX;
    __device__ __forceinline__ void mid(f32x4 (&acc)[2][2][4][2], const Unit& u, int wr, int wc, int fr, int fq) const {
        const int row0 = u.pm * BM + wr * 64 + fr, col0 = u.pn * BM + wc * 32 + 4 * fq;
#pragma unroll
        for (int ai = 0; ai < 2; ++ai)
#pragma unroll
            for (int m = 0; m < 4; ++m) { const bf16_t* rp = Rb + (size_t)(row0 + ai * HALF + m * 16) * DM + col0;
#pragma unroll
                for (int bj = 0; bj < 2; ++bj)
#pragma unroll
                    for (int n = 0; n < 2; ++n) { const u32x2 w = *(const u32x2*)(rp + bj * HALF + n * 16); f32x4 r; r[0] = bf_lo(w.x); r[1] = bf_hi(w.x); r[2] = bf_lo(w.y); r[3] = bf_hi(w.y);
                        acc[ai][bj][m][n] = acc[ai][bj][m][n] * r; }
                asm volatile("" ::: "memory"); }
    }
    __device__ __forceinline__ void operator()(const f32x4 (&acc)[2][2][4][2], const Unit& u, int wr, int wc, int fr, int fq) const {
        const int row0 = u.pm * BM + wr * 64 + fr, col0 = u.pn * BM + wc * 32 + 4 * fq;
#pragma unroll
        for (int ai = 0; ai < 2; ++ai)
#pragma unroll
            for (int m = 0; m < 4; ++m) { const size_t ro = (size_t)(row0 + ai * HALF + m * 16) * DM + col0;
#pragma unroll
                for (int bj = 0; bj < 2; ++bj)
#pragma unroll
                    for (int n = 0; n < 2; ++n) { const u32x2 w = *(const u32x2*)(SMb + ro + bj * HALF + n * 16); const f32x4 v = acc[ai][bj][m][n];
                        u32x2 o; o.x = cvt_pk_bf16(v[0] * bf_lo(w.x), v[1] * bf_hi(w.x)); o.y = cvt_pk_bf16(v[2] * bf_lo(w.y), v[3] * bf_hi(w.y));
                        *(u32x2*)(MIX + ro + bj * HALF + n * 16) = o; }
                asm volatile("" ::: "memory"); }
    }
};
struct EpiRes {
    static constexpr bool PERM = false, AFTER_DRAIN = false;
    const float* bp; const float* bs; float* X;
    __device__ __forceinline__ void mid(f32x4 (&)[2][2][4][2], const Unit&, int, int, int, int) const {}
    __device__ __forceinline__ void operator()(const f32x4 (&acc)[2][2][4][2], const Unit& u, int wr, int wc, int fr, int fq) const {
        const int row0 = u.pm * BM + wr * 64 + fr, col0 = u.pn * BM + wc * 32 + 4 * fq;
#pragma unroll
        for (int ai = 0; ai < 2; ++ai)
#pragma unroll
            for (int m = 0; m < 4; ++m) { const int row = row0 + ai * HALF + m * 16;
                if (row < NROWS) { const float* b = (row < NTOK_P ? bp + (size_t)row * DM : bs + (size_t)(row - NTOK_P) * DM) + col0; float* xo = X + (size_t)row * DM + col0;
#pragma unroll
                    for (int bj = 0; bj < 2; ++bj)
#pragma unroll
                        for (int n = 0; n < 2; ++n) { const f32x4 bv = *(const f32x4*)(b + bj * HALF + n * 16); *(f32x4*)(xo + bj * HALF + n * 16) = bv + acc[ai][bj][m][n]; } } }
    }
};
struct EpiSwiglu {
    static constexpr bool PERM = false, AFTER_DRAIN = false;
    bf16_t* ACT;
    __device__ __forceinline__ void mid(f32x4 (&)[2][2][4][2], const Unit&, int, int, int, int) const {}
    __device__ __forceinline__ void operator()(const f32x4 (&acc)[2][2][4][2], const Unit& u, int wr, int wc, int fr, int fq) const {
        const int row0 = u.pm * BM + wr * 64 + fr, ch0 = u.pn * 128 + wc * 32 + 4 * fq;
#pragma unroll
        for (int ai = 0; ai < 2; ++ai)
#pragma unroll
            for (int m = 0; m < 4; ++m) { bf16_t* rowp = ACT + (size_t)(row0 + ai * HALF + m * 16) * DFF + ch0;
#pragma unroll
                for (int n = 0; n < 2; ++n) { const f32x4 g = acc[ai][0][m][n], up = acc[ai][1][m][n]; float a[4];
#pragma unroll
                    for (int e = 0; e < 4; ++e) a[e] = g[e] * sigmoidf_(g[e]) * up[e];
                    u32x2 w; w.x = cvt_pk_bf16(a[0], a[1]); w.y = cvt_pk_bf16(a[2], a[3]); *(u32x2*)(rowp + n * 16) = w; } }
    }
};

template <class Epi, class Sched, bool ALIGN_EPI = false, bool SP2 = false, int MIDT = 0>
__device__ __forceinline__ void gemm_phase(PG8_LAS unsigned char* lds, const Gemm g, const Sched& S, const Epi& E, const int wid, const int lane) {
    const int tid = wid * 64 + lane, wr = wid >> 2, wc = wid & 3, fr = lane & 15, fq = lane >> 4;
    const int K = g.K, nt = K / BK;
    unsigned voffA[2], voffB[2];
#pragma unroll
    for (int i = 0; i < 2; ++i) { int R, C; stage_rc(tid * 16 + i * 8192, R, C); const int Rb = Epi::PERM ? ((R & ~31) + perm32(R & 31)) : R;
        voffA[i] = (unsigned)(R * K + C) * 2u; voffB[i] = (unsigned)(Rb * K + C) * 2u; }
    const size_t kstep = (size_t)(BK * 2);
    const size_t hstep = (size_t)HALF * K * 2;
    const size_t tstep = 2 * hstep;
    const unsigned ldsw = (unsigned)wid * 1024u;
    const int aoff = lds_byte(wr * 64 + fr, fq * 8), boff = lds_byte(wc * 32 + fr, fq * 8);
#define PG8_SA(b, h) (((b) * 2 + (h)) * HTB)
#define PG8_SB(b, h) ((4 + (b) * 2 + (h)) * HTB)
#define PG8_STAGE(bufoff, gbase, voff) do { _Pragma("unroll") for (int _i = 0; _i < 2; ++_i) \
        __builtin_amdgcn_global_load_lds((const unsigned*)((const char*)(gbase) + (voff)[_i]), (PG8_LAS unsigned*)(lds + (bufoff) + ldsw + _i * 8192), 16, 0, 0); } while (0)
#define PG8_LDA(dst, b, h) do { _Pragma("unroll") for (int m = 0; m < 4; ++m) _Pragma("unroll") for (int k = 0; k < 2; ++k) dst[m][k] = *(const PG8_LAS bf16x8*)(lds + PG8_SA(b, h) + aoff + m * 2048 + k * 1024); } while (0)
#define PG8_LDB(dst, b, h) do { _Pragma("unroll") for (int n = 0; n < 2; ++n) _Pragma("unroll") for (int k = 0; k < 2; ++k) dst[n][k] = *(const PG8_LAS bf16x8*)(lds + PG8_SB(b, h) + boff + n * 2048 + k * 1024); } while (0)
#define PG8_MMA(ai, bj, At, Bt) do { __builtin_amdgcn_s_setprio(1); _Pragma("unroll") for (int m = 0; m < 4; ++m) _Pragma("unroll") for (int n = 0; n < 2; ++n) _Pragma("unroll") for (int k = 0; k < 2; ++k) \
        acc[ai][bj][m][n] = __builtin_amdgcn_mfma_f32_16x16x32_bf16(Bt[n][k], At[m][k], acc[ai][bj][m][n], 0, 0, 0); __builtin_amdgcn_s_setprio(0); } while (0)
#define PG8_WAIT_V(n) asm volatile("s_waitcnt vmcnt(" #n ")" ::: "memory")
#define PG8_WAIT_L(n) asm volatile("s_waitcnt lgkmcnt(" #n ")" ::: "memory")
#define PG8_BAR __builtin_amdgcn_s_barrier()
#define PG8_SCHED __builtin_amdgcn_sched_barrier(0)
    Unit cur, nxt; int ui = 0;
    if (!S.next(0, cur)) return;
    f32x4 acc[2][2][4][2];
#pragma unroll
    for (int a = 0; a < 2; ++a)
#pragma unroll
        for (int b = 0; b < 2; ++b)
#pragma unroll
            for (int m = 0; m < 4; ++m)
#pragma unroll
                for (int n = 0; n < 2; ++n) acc[a][b][m][n] = (f32x4){0.f, 0.f, 0.f, 0.f};
    bf16x8 At[4][2], B0[2][2], B1[2][2];
    const char* cA = (const char*)g.A + (size_t)cur.pm * tstep; const char* cB = (const char*)g.Bt + (size_t)cur.pn * tstep;
    S.a_ready(cur);
    if constexpr (SP2) {
        PG8_STAGE(PG8_SB(0, 0), cB, voffB); PG8_STAGE(PG8_SB(0, 1), cB + hstep, voffB); PG8_STAGE(PG8_SA(0, 0), cA, voffA); PG8_STAGE(PG8_SA(0, 1), cA + hstep, voffA);
        if (wr == 1) PG8_BAR;
        PG8_WAIT_V(2); PG8_BAR;
        PG8_STAGE(PG8_SB(1, 0), cB + kstep, voffB); PG8_STAGE(PG8_SA(1, 0), cA + kstep, voffA); PG8_STAGE(PG8_SB(1, 1), cB + hstep + kstep, voffB);
        PG8_WAIT_V(6); PG8_BAR;
    } else {
        PG8_STAGE(PG8_SB(0, 0), cB, voffB); PG8_STAGE(PG8_SA(0, 0), cA, voffA); PG8_STAGE(PG8_SB(0, 1), cB + hstep, voffB); PG8_STAGE(PG8_SA(0, 1), cA + hstep, voffA);
        if (wr == 1) PG8_BAR;
        PG8_WAIT_V(4); PG8_BAR;
        PG8_STAGE(PG8_SB(1, 0), cB + kstep, voffB); PG8_STAGE(PG8_SA(1, 0), cA + kstep, voffA); PG8_STAGE(PG8_SB(1, 1), cB + hstep + kstep, voffB);
        PG8_WAIT_V(6); PG8_BAR;
    }
    for (;;) {
        const bool has_next = S.next(ui + 1, nxt);
        const char* nA = has_next ? (const char*)g.A + (size_t)nxt.pm * tstep : cA; const char* nB = has_next ? (const char*)g.Bt + (size_t)nxt.pn * tstep : cB;
        for (int t = 0; t < nt; t += 2) {
            if constexpr (MIDT > 0) { if (t == MIDT) E.mid(acc, cur, wr, wc, fr, fq); }
            const bool last = (t == nt - 2);
            const char* a1 = cA + (size_t)(t + 1) * kstep;
            const char* a2 = last ? nA : cA + (size_t)(t + 2) * kstep; const char* b2 = last ? nB : cB + (size_t)(t + 2) * kstep;
            const char* a3 = a2 + kstep; const char* b3 = b2 + kstep;
            if (last && has_next) S.a_ready(nxt);
            if constexpr (SP2) {
            PG8_LDB(B0, 0, 0); PG8_LDB(B1, 0, 1); PG8_SCHED; PG8_LDA(At, 0, 0); PG8_STAGE(PG8_SA(1, 1), a1 + hstep, voffA);
            PG8_WAIT_V(8); PG8_WAIT_L(0); PG8_BAR; PG8_MMA(0, 0, At, B0); PG8_MMA(0, 1, At, B1); PG8_BAR; PG8_SCHED;
            PG8_LDA(At, 0, 1); PG8_STAGE(PG8_SB(0, 0), b2, voffB); PG8_STAGE(PG8_SB(0, 1), b2 + hstep, voffB); PG8_STAGE(PG8_SA(0, 0), a2, voffA);
            PG8_WAIT_V(8); PG8_WAIT_L(0); PG8_BAR; PG8_MMA(1, 0, At, B0); PG8_MMA(1, 1, At, B1); PG8_BAR; PG8_SCHED;
            PG8_LDB(B0, 1, 0); PG8_LDB(B1, 1, 1); PG8_SCHED; PG8_LDA(At, 1, 0); PG8_STAGE(PG8_SA(0, 1), a2 + hstep, voffA);
            PG8_WAIT_V(8); PG8_WAIT_L(0); PG8_BAR; PG8_MMA(0, 0, At, B0); PG8_MMA(0, 1, At, B1); PG8_BAR; PG8_SCHED;
            PG8_LDA(At, 1, 1); PG8_STAGE(PG8_SB(1, 0), b3, voffB); PG8_STAGE(PG8_SB(1, 1), b3 + hstep, voffB); PG8_STAGE(PG8_SA(1, 0), a3, voffA);
            PG8_WAIT_V(8); PG8_WAIT_L(0); PG8_BAR; PG8_MMA(1, 0, At, B0); PG8_MMA(1, 1, At, B1); PG8_BAR; PG8_SCHED;
            } else {
            PG8_LDB(B0, 0, 0); PG8_SCHED; PG8_LDA(At, 0, 0); PG8_STAGE(PG8_SA(1, 1), a1 + hstep, voffA);
            PG8_WAIT_L(8); PG8_BAR; PG8_WAIT_L(0); PG8_MMA(0, 0, At, B0); PG8_BAR; PG8_SCHED;
            PG8_LDB(B1, 0, 1); PG8_STAGE(PG8_SB(0, 0), b2, voffB);
            PG8_BAR; PG8_WAIT_L(0); PG8_MMA(0, 1, At, B1); PG8_BAR;
            PG8_LDA(At, 0, 1); PG8_STAGE(PG8_SA(0, 0), a2, voffA);
            PG8_BAR; PG8_WAIT_L(0); PG8_MMA(1, 0, At, B0); PG8_BAR; PG8_SCHED;
            PG8_STAGE(PG8_SB(0, 1), b2 + hstep, voffB);
            PG8_WAIT_V(6); PG8_BAR; PG8_MMA(1, 1, At, B1); PG8_BAR;
            PG8_LDB(B0, 1, 0); PG8_SCHED; PG8_LDA(At, 1, 0); PG8_STAGE(PG8_SA(0, 1), a2 + hstep, voffA);
            PG8_WAIT_L(8); PG8_BAR; PG8_WAIT_L(0); PG8_MMA(0, 0, At, B0); PG8_BAR; PG8_SCHED;
            PG8_LDB(B1, 1, 1); PG8_STAGE(PG8_SB(1, 0), b3, voffB);
            PG8_BAR; PG8_WAIT_L(0); PG8_MMA(0, 1, At, B1); PG8_BAR;
            PG8_LDA(At, 1, 1); PG8_STAGE(PG8_SA(1, 0), a3, voffA);
            PG8_BAR; PG8_WAIT_L(0); PG8_MMA(1, 0, At, B0); PG8_BAR; PG8_SCHED;
            PG8_STAGE(PG8_SB(1, 1), b3 + hstep, voffB);
            PG8_WAIT_V(6); PG8_BAR; PG8_MMA(1, 1, At, B1); PG8_BAR;
            }
        }
        if constexpr (ALIGN_EPI) { if (wr == 0) PG8_BAR; }
        E(acc, cur, wr, wc, fr, fq); S.done(cur);
        if (!has_next) break;
#pragma unroll
        for (int a = 0; a < 2; ++a)
#pragma unroll
            for (int b = 0; b < 2; ++b)
#pragma unroll
                for (int m = 0; m < 4; ++m)
#pragma unroll
                    for (int n = 0; n < 2; ++n) acc[a][b][m][n] = (f32x4){0.f, 0.f, 0.f, 0.f};
        cur = nxt; cA = nA; cB = nB; ++ui;
        if constexpr (ALIGN_EPI) { if (wr == 1) PG8_BAR; }
    }
    PG8_WAIT_V(0);
    if constexpr (!ALIGN_EPI) { if (wr == 0) PG8_BAR; }
    PG8_BAR;
#undef PG8_SA
#undef PG8_SB
#undef PG8_STAGE
#undef PG8_LDA
#undef PG8_LDB
#undef PG8_MMA
#undef PG8_WAIT_V
#undef PG8_WAIT_L
#undef PG8_BAR
#undef PG8_SCHED
}
}

#ifndef PG8_SP2
#define PG8_SP2 true
#endif
#ifndef PG8_ALIGN
#define PG8_ALIGN true
#endif

constexpr int NWAVES = 8;
constexpr int N_PHASES = 11;
#ifndef MK_ONE_LAUNCH
#define MK_ONE_LAUNCH 1
#endif

constexpr size_t MiB = 1u << 20;
constexpr size_t WS_CTL = 0, CTL_ZERO_BYTES = 1 * MiB;
constexpr size_t WS_W1 = 2 * MiB;
constexpr size_t WS_W2 = 11 * MiB;
constexpr size_t WS_W3 = 13 * MiB;
constexpr size_t WS_W4 = 15 * MiB;
constexpr size_t WS_W5 = 26 * MiB;
constexpr size_t WS_IG = 32 * MiB;
constexpr size_t WS_LF = 32 * MiB + 512 * 1024;
constexpr size_t WS_H = 33 * MiB;
constexpr size_t WS_Z = 66 * MiB;
constexpr size_t WS_R = 140 * MiB;
constexpr size_t WS_SMG = 173 * MiB;
constexpr size_t WS_Y = 206 * MiB;
constexpr size_t WS_MIX = WS_Z;
constexpr size_t WS_ACT = WS_Z;
constexpr size_t WS_SC = 239 * MiB;
constexpr size_t WS_U = WS_H;
constexpr size_t WS_CP = WS_H + 17 * MiB;
constexpr size_t WS_NP = WS_H + 25 * MiB;
constexpr size_t WS_HRS = WS_H + 26 * MiB;
constexpr size_t WS_END = 256 * MiB;
static_assert(WS_U + (size_t)512 * 8256 * 4 <= WS_CP && WS_HRS + 128 * 512 * 4 <= WS_Z, "ws map 4");
static_assert(WS_W1 + (size_t)NG1 * DM * 2 <= WS_W2 && WS_W4 + (size_t)NFF2 * DM * 2 <= WS_W5 && WS_W5 + (size_t)DM * DFF * 2 <= WS_IG, "ws map 1");
static_assert(WS_H + (size_t)MPAD * DM * 2 <= WS_Z && WS_Z + (size_t)MPAD * NZ * 2 <= WS_R && WS_R + (size_t)MPAD * DM * 2 <= WS_SMG && WS_SMG + (size_t)MPAD * DM * 2 <= WS_Y && WS_Y + (size_t)MPAD * DM * 2 <= WS_END, "ws map 2");
static_assert(WS_ACT + (size_t)MPAD * DFF * 2 <= WS_SMG, "ws map 3");
constexpr int CW_BAR = 4096;

constexpr int RING_OFF = 0, RING_BYTES = 131072;
constexpr int LDSCTL_OFF = RING_BYTES, MISC_OFF = LDSCTL_OFF + 320;
constexpr int LDS_BYTES = 147456;

#define GAS __attribute__((address_space(1)))
#define LAS __attribute__((address_space(3)))
typedef unsigned short bf16;
typedef unsigned v4u __attribute__((ext_vector_type(4)));
typedef unsigned v2u __attribute__((ext_vector_type(2)));
typedef float f32x4 __attribute__((ext_vector_type(4)));
typedef GAS unsigned gu32;
#define RLX_AGENT __ATOMIC_RELAXED, __HIP_MEMORY_SCOPE_AGENT
#define LDS_WAIT() asm volatile("s_waitcnt lgkmcnt(0)" ::: "memory")
#define VM_WAIT() asm volatile("s_waitcnt vmcnt(0)" ::: "memory")
__device__ __forceinline__ unsigned f2bf(float f) { unsigned u = __builtin_bit_cast(unsigned, f); return (u + 0x7fffu + ((u >> 16) & 1u)) >> 16; }
__device__ __forceinline__ unsigned pk2(float lo, float hi) { return f2bf(lo) | (f2bf(hi) << 16); }
__device__ __forceinline__ float bf2f(unsigned short b) { return __uint_as_float((unsigned)b << 16); }

#define XB_TMO      128
#define XB_XCNT(j)  (256  + 64 * (j))
#define XB_XSUB(j)  (1280 + 64 * (j))
#define XB_XGEN(j)  (2304 + 64 * (j))
#define XB_TOP      3328
#define XB_TOPGEN   3392
#define XCD_BAR_WORDS 3456
#define XB_SPIN_CAP (1u << 18)
__device__ __forceinline__ unsigned xb_ld(unsigned* p)              { return __hip_atomic_load(p, __ATOMIC_RELAXED, __HIP_MEMORY_SCOPE_AGENT); }
__device__ __forceinline__ unsigned xb_add(unsigned* p, unsigned v) { return __hip_atomic_fetch_add(p, v, __ATOMIC_RELAXED, __HIP_MEMORY_SCOPE_AGENT); }
__device__ __forceinline__ unsigned xb_xcc_id() { return (unsigned)__builtin_amdgcn_s_getreg((3 << 11) | 20) & 0xFu; }
#define XB_SPIN(cond, bar) do { unsigned _sp = 0; while (cond) { __builtin_amdgcn_s_sleep(1); \
    if ((++_sp & 255u) == 0u) { if (xb_ld(&(bar)[XB_TMO])) break; if (_sp > XB_SPIN_CAP) { atomicAdd(&(bar)[XB_TMO], 1u); break; } } } } while (0)
struct XcdBarrier { unsigned* bar; unsigned x; volatile LAS unsigned* st; };
__device__ __forceinline__ XcdBarrier xcd_barrier_post(unsigned* bar, volatile LAS unsigned* st) {
    XcdBarrier b; b.bar = bar; b.x = xb_xcc_id(); b.st = st;
    if (threadIdx.x == 0) (void)xb_add(&bar[XB_XCNT(b.x)], 1u);
    return b;
}
__device__ __forceinline__ void xcd_barrier_complete(unsigned* bar, unsigned x, unsigned& nloc, unsigned& nx) {
    const unsigned G = gridDim.x * gridDim.y * gridDim.z;
    unsigned sum, cnt, mine, sp = 0u;
    for (;;) {
        sum = 0u; cnt = 0u; mine = 0u;
#pragma unroll
        for (unsigned j = 0; j < 16; ++j) { const unsigned c = xb_ld(&bar[XB_XCNT(j)]); sum += c; cnt += (c > 0u) ? 1u : 0u; mine = (j == x) ? c : mine; }
        if (sum == G) break;
        __builtin_amdgcn_s_sleep(1);
        if ((++sp & 255u) == 0u) { if (xb_ld(&bar[XB_TMO])) break; if (sp > XB_SPIN_CAP) { atomicAdd(&bar[XB_TMO], 1u); break; } }
    }
    nloc = mine > 0u ? mine : 1u; nx = cnt > 0u ? cnt : 1u;
}
__device__ __forceinline__ void xcd_barrier(const XcdBarrier& b) {
    asm volatile("s_waitcnt vmcnt(0)" ::: "memory");
    __syncthreads();
    if (threadIdx.x == 0) {
        unsigned* bar = b.bar;
        __builtin_amdgcn_s_waitcnt(0);
        unsigned nloc = b.st[0], nx = b.st[1];
        if (nloc == 0u) { xcd_barrier_complete(bar, b.x, nloc, nx); b.st[0] = nloc; b.st[1] = nx; }
        const unsigned old = xb_add(&bar[XB_XSUB(b.x)], 1u);
        const unsigned gen = old / nloc;
        if (old + 1u == (gen + 1u) * nloc) {
            __builtin_amdgcn_fence(__ATOMIC_RELEASE, "agent");
            asm volatile("s_waitcnt vmcnt(0)" ::: "memory");
            const unsigned og = xb_add(&bar[XB_TOP], 1u);
            const unsigned tg = og / nx;
            if (og + 1u == (tg + 1u) * nx) xb_add(&bar[XB_TOPGEN], 1u);
            else XB_SPIN(xb_ld(&bar[XB_TOPGEN]) == tg, bar);
            __builtin_amdgcn_fence(__ATOMIC_ACQUIRE, "agent");
            xb_add(&bar[XB_XGEN(b.x)], 1u);
            asm volatile("s_waitcnt vmcnt(0)" ::: "memory");
        } else {
            XB_SPIN(xb_ld(&bar[XB_XGEN(b.x)]) == gen, bar);
            __builtin_amdgcn_fence(__ATOMIC_ACQUIRE, "agent");
            asm volatile("s_waitcnt vmcnt(0)" ::: "memory");
        }
    }
    __syncthreads();
}

struct Args { const float* in[21]; float* out; unsigned char* ws; int ph_lo, ph_hi, li, pad; };
struct Frame {
    LAS unsigned char* lds;
    volatile LAS unsigned* MISC;
    int wave;
    int vcu, G;
    const Args* a;
};
__device__ __forceinline__ int lane_id_fresh() { int l; asm volatile("v_mbcnt_lo_u32_b32 %0, -1, 0\n\tv_mbcnt_hi_u32_b32 %0, -1, %0" : "=v"(l)); return l; }
#define A_IN(i) (F.a->in[i])
#define xp_ A_IN(0)
#define xs_ A_IN(1)
#define cache_k_ A_IN(2)
#define cache_v_ A_IN(3)
#define stC_ A_IN(4)
#define stN_ A_IN(5)
#define stM_ A_IN(6)
#define rel_bias_ A_IN(7)
#define w_in_ A_IN(8)
#define b_if_ A_IN(9)
#define sinks_ A_IN(10)
#define g_attn_ A_IN(11)
#define g_head_ A_IN(12)
#define w_att_out_ A_IN(13)
#define w_mlstm_out_ A_IN(14)
#define w_out_ A_IN(15)
#define g_ffn_ A_IN(16)
#define w_gate_ A_IN(17)
#define w_up_ A_IN(18)
#define w_down_ A_IN(19)
#define g_final_ A_IN(20)
#define out_ (F.a->out)
#define WSP(T, off) ((T*)(F.a->ws + (off)))
#define W1_ WSP(bf16, WS_W1)
#define W2_ WSP(bf16, WS_W2)
#define W3_ WSP(bf16, WS_W3)
#define W4_ WSP(bf16, WS_W4)
#define W5_ WSP(bf16, WS_W5)
#define H_ WSP(bf16, WS_H)
#define Z_ WSP(bf16, WS_Z)
#define R_ WSP(bf16, WS_R)
#define SMG_ WSP(bf16, WS_SMG)
#define Y_ WSP(bf16, WS_Y)
#define MIX_ WSP(bf16, WS_MIX)
#define ACT_ WSP(bf16, WS_ACT)
#define IG_ WSP(float, WS_IG)
#define LF_ WSP(float, WS_LF)
#define HRS_ WSP(float, WS_HRS)
#define CP_ WSP(bf16, WS_CP)
#define NP_ WSP(float, WS_NP)
#define SC_ WSP(float, WS_SC)
#define UB_ WSP(float, WS_U)

__device__ __forceinline__ float wave_sum(float v) {
#pragma unroll
    for (int o = 1; o < 64; o <<= 1) v += __shfl_xor(v, o);
    return v;
}

__device__ __forceinline__ void tr_item(const float* W, int ldw, int k0, int n0, bf16* WT, int ldt, int r0, int c0, LAS float* scr, int lane) {
#pragma unroll 8
    for (int i = 0; i < 32; ++i) { const int kk = 2 * i + (lane >> 5); scr[kk * 33 + (lane & 31)] = W[(size_t)(k0 + kk) * ldw + n0 + (lane & 31)]; }
    LDS_WAIT(); asm volatile("" ::: "memory");
    const int c = lane & 7;
#pragma unroll
    for (int j = 0; j < 4; ++j) { const int n = (lane >> 3) + 8 * j; const LAS float* s = scr + (8 * c) * 33 + n;
        v4u o; o.x = pk2(s[0 * 33], s[1 * 33]); o.y = pk2(s[2 * 33], s[3 * 33]); o.z = pk2(s[4 * 33], s[5 * 33]); o.w = pk2(s[6 * 33], s[7 * 33]);
        *(GAS v4u*)(WT + (size_t)(r0 + n) * ldt + c0 + 8 * c) = o; }
    LDS_WAIT(); asm volatile("" ::: "memory");
}
__device__ __forceinline__ float log_sigmoid(float x) { return fminf(x, 0.f) - log1pf(__expf(-fabsf(x))); }

__device__ __forceinline__ void p0_prologue(Frame& F) {
    const int LN_ = lane_id_fresh(); const int TID_ = F.wave * 64 + LN_; (void)TID_;
    LAS float* scr = (LAS float*)(F.lds + RING_OFF + F.wave * 16384);
    const int gw = F.vcu * NWAVES + F.wave, NGW = F.G * NWAVES;
    constexpr int I1 = 16 * (NG1 / 32), I2 = 16 * 32, I3 = 16 * 32, I4 = 16 * (NFF2 / 32), I5 = (DFF / 64) * 32;
    constexpr int NITEMS = I1 + I2 + I3 + I4 + I5;
    for (int it = gw; it < NITEMS; it += NGW) {
        int r = it;
        if (r < I1) { const int kb = r / (NG1 / 32), nb = r % (NG1 / 32), d = 32 * nb; int n0;
            if (d < NZ) n0 = d; else { const int t = (d - NZ) / 256, j = (d - NZ) % 256; n0 = (j < 128) ? (WC_GA + t * 128 + j) : (WC_GM + t * 128 + j - 128); }
            tr_item(w_in_, NIN, 64 * kb, n0, W1_, DM, d, 64 * kb, scr, LN_); continue; } r -= I1;
        if (r < I2) { const int kb = r / 32, nb = r % 32;
            if (kb < 8) tr_item(w_att_out_, DM, 64 * kb, 32 * nb, W2_, DM, 32 * nb, 64 * kb, scr, LN_);
            else tr_item(w_mlstm_out_, DM, 64 * (kb - 8), 32 * nb, W2_, DM, 32 * nb, 64 * kb, scr, LN_);
            continue; } r -= I2;
        if (r < I3) { const int kb = r / 32, nb = r % 32; tr_item(w_out_, DM, 64 * kb, 32 * nb, W3_, DM, 32 * nb, 64 * kb, scr, LN_); continue; } r -= I3;
        if (r < I4) { const int kb = r / (NFF2 / 32), rb = r % (NFF2 / 32), d = 32 * rb, t = d / 256, j = d % 256;
            if (j < 128) tr_item(w_gate_, DFF, 64 * kb, t * 128 + j, W4_, DM, d, 64 * kb, scr, LN_);
            else tr_item(w_up_, DFF, 64 * kb, t * 128 + j - 128, W4_, DM, d, 64 * kb, scr, LN_);
            continue; } r -= I4;
        { const int kb = r / 32, nb = r % 32; tr_item(w_down_, DM, 64 * kb, 32 * nb, W5_, DFF, 32 * nb, 64 * kb, scr, LN_); }
    }
    __syncthreads();
    LAS float* wif = (LAS float*)(F.lds + RING_OFF);
    for (int i = TID_; i < 8 * DM; i += NWAVES * 64) { const int g = i >> 10, k = i & (DM - 1); wif[i] = w_in_[(size_t)k * NIN + WC_IF + g] * g_attn_[k]; }
    __syncthreads();
    const LAS f32x4* wif4 = (const LAS f32x4*)wif;
    for (int row = gw; row < NROWS; row += NGW) {
        const float* xrow = row < NTOK_P ? xp_ + (size_t)row * DM : xs_ + (size_t)(row - NTOK_P) * DM;
        const GAS f32x4* xr = (const GAS f32x4*)xrow + LN_;
        f32x4 v[4]; float ss = 0.f; float gd[8];
#pragma unroll
        for (int g = 0; g < 8; ++g) gd[g] = 0.f;
#pragma unroll
        for (int j = 0; j < 4; ++j) { v[j] = xr[64 * j]; ss += (v[j].x * v[j].x + v[j].y * v[j].y) + (v[j].z * v[j].z + v[j].w * v[j].w); }
#pragma unroll
        for (int j = 0; j < 4; ++j)
#pragma unroll
            for (int g = 0; g < 8; ++g) { const f32x4 w = wif4[g * 256 + 64 * j + LN_]; gd[g] += (v[j].x * w.x + v[j].y * w.y) + (v[j].z * w.z + v[j].w * w.w); }
        ss = wave_sum(ss);
#pragma unroll
        for (int g = 0; g < 8; ++g) gd[g] = wave_sum(gd[g]);
        const float rstd = 1.0f / sqrtf(ss * (1.0f / DM) + EPS);
        GAS unsigned long long* o8 = (GAS unsigned long long*)(H_ + (size_t)row * DM) + LN_;
#pragma unroll
        for (int j = 0; j < 4; ++j) { const f32x4 gg = *((const GAS f32x4*)g_attn_ + 64 * j + LN_);
            o8[64 * j] = (unsigned long long)pk2(v[j].x * rstd * gg.x, v[j].y * rstd * gg.y) | ((unsigned long long)pk2(v[j].z * rstd * gg.z, v[j].w * rstd * gg.w) << 32); }
        if (LN_ == 0) {
            f32x4 ig, lf;
            ig.x = gd[0] * rstd + b_if_[0]; ig.y = gd[1] * rstd + b_if_[1]; ig.z = gd[2] * rstd + b_if_[2]; ig.w = gd[3] * rstd + b_if_[3];
            lf.x = log_sigmoid(gd[4] * rstd + b_if_[4]); lf.y = log_sigmoid(gd[5] * rstd + b_if_[5]); lf.z = log_sigmoid(gd[6] * rstd + b_if_[6]); lf.w = log_sigmoid(gd[7] * rstd + b_if_[7]);
            *(f32x4*)(IG_ + (size_t)row * 4) = ig; *(f32x4*)(LF_ + (size_t)row * 4) = lf;
        }
    }
    { const int gt = F.vcu * (NWAVES * 64) + TID_, NGT = F.G * NWAVES * 64; constexpr int NPAD16 = (MPAD - NROWS) * DM * 2 / 16;
      GAS v4u* hp = (GAS v4u*)(H_ + (size_t)NROWS * DM);
      for (int i = gt; i < NPAD16; i += NGT) hp[i] = (v4u){0u, 0u, 0u, 0u};
      constexpr int PERB = 127 * 128 / 4;
      for (int i = gt; i < NSAMP * PERB; i += NGT) { const int b = i / PERB, o = i % PERB;
          const f32x4 kk = *((const GAS f32x4*)(cache_k_ + (size_t)b * 16384 + 128) + o); const f32x4 vv = *((const GAS f32x4*)(cache_v_ + (size_t)b * 16384 + 128) + o);
          *((GAS f32x4*)(out_ + OFF_SK + (size_t)b * 16384) + o) = kk; *((GAS f32x4*)(out_ + OFF_SV + (size_t)b * 16384) + o) = vv; }
    }
}

__device__ __forceinline__ int t5_bucket(int n) {
    if (n < 16) return n;
    const float v = logf((float)n * (1.0f / 16.0f)) / 2.0794415416798357f * 16.0f;
    const int l = 16 + (int)v; return l < 31 ? l : 31;
}
__device__ __forceinline__ void mlstm_chain(Frame& F, const int LN_, int r0, int S, int h, int vs, const float* C0, const float* n0, const float* m0, float* Cout, float* nout, float* mout, float* hout) {
    const int lane = LN_;
    float C[8], nn, m;
#pragma unroll
    for (int i = 0; i < 8; ++i) C[i] = C0 ? C0[(size_t)(vs * 8 + i) * 64 + lane] : 0.f;
    nn = n0 ? n0[lane] : 0.f; m = m0 ? m0[0] : 0.f;
    for (int t = 0; t < S; ++t) {
        const size_t row = (size_t)(r0 + t);
        const bf16* zr = Z_ + row * NZ;
        const float q = bf2f(zr[ZC_QM + h * 64 + lane]), k = bf2f(zr[ZC_KM + h * 64 + lane]) * 0.125f;
        const v4u vraw = *(const v4u*)(zr + ZC_VM + h * 128 + vs * 8);
        const float ig = IG_[row * 4 + h], lf = LF_[row * 4 + h];
        float vv[8]; vv[0] = pg8::bf_lo(vraw.x); vv[1] = pg8::bf_hi(vraw.x); vv[2] = pg8::bf_lo(vraw.y); vv[3] = pg8::bf_hi(vraw.y); vv[4] = pg8::bf_lo(vraw.z); vv[5] = pg8::bf_hi(vraw.z); vv[6] = pg8::bf_lo(vraw.w); vv[7] = pg8::bf_hi(vraw.w);
        const float mn = fmaxf(lf + m, ig), fd = __expf(lf + m - mn), iw = __expf(ig - mn);
        float num[8];
#pragma unroll
        for (int i = 0; i < 8; ++i) { C[i] = fd * C[i] + iw * vv[i] * k; num[i] = wave_sum(C[i] * q); }
        nn = fd * nn + iw * k; m = mn;
        const float den = fmaxf(fabsf(wave_sum(nn * q)), __expf(-mn));
        float o = num[0];
#pragma unroll
        for (int i = 1; i < 8; ++i) o = (lane == i) ? num[i] : o;
        if (lane < 8) hout[(size_t)t * 512 + h * 128 + vs * 8 + lane] = o / den;
    }
#pragma unroll
    for (int i = 0; i < 8; ++i) Cout[(size_t)(vs * 8 + i) * 64 + lane] = C[i];
    if (vs == 0) { nout[lane] = nn; if (lane == 0) mout[0] = m; }
}
__device__ __forceinline__ void attn_item_prompt(Frame& F, const int LN_, int row, int hq) {
    const int lane = LN_, b = row >> 13, t = row & (SEQ - 1), kvh = hq >> 2;
    const float q = bf2f(Z_[(size_t)row * NZ + ZC_QA + hq * 64 + lane]) * 0.125f;
    float m = sinks_[hq], l = 1.0f, acc = 0.f;
    const int j0 = t - 127 < 0 ? 0 : t - 127;
    for (int j = j0; j <= t; ++j) {
        const bf16* zr = Z_ + (size_t)(b * SEQ + j) * NZ;
        const float kd = bf2f(zr[ZC_KA + kvh * 64 + lane]), vd = bf2f(zr[ZC_VA + kvh * 64 + lane]);
        const float s = wave_sum(q * kd) + rel_bias_[t5_bucket(t - j) * 8 + hq];
        const float mn = fmaxf(m, s), al = __expf(m - mn), p = __expf(s - mn);
        l = l * al + p; acc = acc * al + p * vd; m = mn;
    }
    Y_[(size_t)row * DM + hq * 64 + lane] = (bf16)f2bf(acc / l);
}
__device__ __forceinline__ void attn_item_sample(Frame& F, const int LN_, int b, int hq) {
    const int lane = LN_, kvh = hq >> 2; const size_t row = (size_t)(NTOK_P + b);
    const float q = bf2f(Z_[row * NZ + ZC_QA + hq * 64 + lane]) * 0.125f;
    float m = sinks_[hq], l = 1.0f, acc = 0.f;
    for (int j = 1; j <= 128; ++j) {
        float kd, vd;
        if (j < 128) { kd = cache_k_[((size_t)(b * 128 + j) * 2 + kvh) * 64 + lane]; vd = cache_v_[((size_t)(b * 128 + j) * 2 + kvh) * 64 + lane]; }
        else { kd = bf2f(Z_[row * NZ + ZC_KA + kvh * 64 + lane]); vd = bf2f(Z_[row * NZ + ZC_VA + kvh * 64 + lane]); }
        const float s = wave_sum(q * kd) + rel_bias_[t5_bucket(128 - j) * 8 + hq];
        const float mn = fmaxf(m, s), al = __expf(m - mn), p = __expf(s - mn);
        l = l * al + p; acc = acc * al + p * vd; m = mn;
    }
    Y_[row * DM + hq * 64 + lane] = (bf16)f2bf(acc / l);
}
__device__ __forceinline__ void p2_simple(Frame& F) {
    const int LN_ = lane_id_fresh(); const int TID_ = F.wave * 64 + LN_; (void)TID_;
    const int gw = F.wave * F.G + (int)blockIdx.x, NGW = F.G * NWAVES;
    constexpr int I_SC = NSAMP * 4 * 16, I_AS = NSAMP * 8;
    for (int it = gw; it < I_SC + I_AS; it += NGW) {
        int r = it;
        if (r < I_SC) { const int vs = r & 15, h = (r >> 4) & 3, b = r >> 6;
            mlstm_chain(F, LN_, NTOK_P + b, 1, h, vs, stC_ + (size_t)(b * 4 + h) * 8192, stN_ + (size_t)(b * 4 + h) * 64, stM_ + (b * 4 + h),
                        out_ + OFF_SC + (size_t)(b * 4 + h) * 8192, out_ + OFF_SN + (size_t)(b * 4 + h) * 64, out_ + OFF_SM + (b * 4 + h), HRS_ + (size_t)b * 512); continue; } r -= I_SC;
        attn_item_sample(F, LN_, r >> 3, r & 7);
    }
}

typedef short bf16x8 __attribute__((ext_vector_type(8)));
typedef short s16x4 __attribute__((ext_vector_type(4)));
typedef short v4i16_t __attribute__((ext_vector_type(4)));
typedef float f32x16 __attribute__((ext_vector_type(16)));
typedef LAS const char* lds_cptr;
__device__ __forceinline__ int crow(int r, int hi) { return (r & 3) + 8 * (r >> 2) + 4 * hi; }
__device__ __forceinline__ s16x4 vtr(lds_cptr p) { return __builtin_bit_cast(s16x4, __builtin_amdgcn_ds_read_tr16_b64_v4i16((LAS v4i16_t*)p)); }
__device__ __forceinline__ bf16x8 tr_frag(lds_cptr p0, lds_cptr p1) { const s16x4 a = vtr(p0), b = vtr(p1); return (bf16x8){a[0], a[1], a[2], a[3], b[0], b[1], b[2], b[3]}; }

__device__ __forceinline__ void chain_scan(Frame& F, int chain) {
    const int LN_ = lane_id_fresh(); const int tid = F.wave * 64 + LN_;
    LAS float* red = (LAS float*)(F.lds + RING_OFF);
    const int b = chain >> 2, h = chain & 3;
    const float* igp = IG_ + (size_t)(b * SEQ + tid * 16) * 4 + h; const float* lfp = LF_ + (size_t)(b * SEQ + tid * 16) * 4 + h;
    float igv[16], lfv[16]; float ls = 0.f;
#pragma unroll
    for (int k = 0; k < 16; ++k) { igv[k] = igp[4 * k]; lfv[k] = lfp[4 * k]; }
#pragma unroll
    for (int k = 0; k < 16; ++k) ls += lfv[k];
    float inc = ls;
#pragma unroll
    for (int o = 1; o < 64; o <<= 1) { const float y = __shfl_up(inc, o); if (LN_ >= o) inc += y; }
    if (LN_ == 63) red[F.wave] = inc;
    __syncthreads();
    float bt = inc - ls;
    for (int w = 0; w < F.wave; ++w) bt += red[w];
    float lm = -3.0e38f;
#pragma unroll
    for (int k = 0; k < 16; ++k) { bt += lfv[k]; lfv[k] = bt; igv[k] = igv[k] - bt; lm = fmaxf(lm, igv[k]); }
    float minc = lm;
#pragma unroll
    for (int o = 1; o < 64; o <<= 1) { const float y = __shfl_up(minc, o); if (LN_ >= o) minc = fmaxf(minc, y); }
    float mexc = __shfl_up(minc, 1); if (LN_ == 0) mexc = 0.f;
    if (LN_ == 63) red[8 + F.wave] = minc;
    __syncthreads();
    mexc = fmaxf(mexc, 0.f);
    for (int w = 0; w < F.wave; ++w) mexc = fmaxf(mexc, red[8 + w]);
    float* sa = SC_ + (size_t)chain * SEQ + tid * 16; float* smx = sa + 8 * SEQ; float* smt = sa + 16 * SEQ;
    float run = mexc;
#pragma unroll
    for (int k = 0; k < 16; ++k) { run = fmaxf(run, igv[k]); sa[k] = igv[k]; smx[k] = run; smt[k] = lfv[k] + run; }
    __syncthreads();
}

__device__ __forceinline__ void p2a_mb(Frame& F) {
    const int lane = lane_id_fresh(); const int grp = F.wave >> 2, w4 = F.wave & 3, hh = lane >> 5, l31 = lane & 31, tg = w4 * 64 + lane;
    LAS unsigned char* Vt = F.lds + RING_OFF + grp * 65536; LAS unsigned char* Kt = Vt + 40960;
    LAS float* part = (LAS float*)(F.lds + RING_BYTES + 1024) + grp * 256;
    const float* SA = SC_; const float* SMX = SC_ + 8 * SEQ;
    const int q = (lane & 15) >> 2, p = lane & 3, blk = (lane >> 4) & 1;
    for (int it0 = (int)blockIdx.x * 2; it0 < 512; it0 += 2 * F.G) {
        const int it = it0 + grp, chain = it >> 6, c = it & 63, b = chain >> 2, h = chain & 3;
        const size_t row0 = (size_t)b * SEQ + (size_t)c * 128;
        const float* sac = SA + (size_t)chain * SEQ + c * 128;
        const float mxe = SMX[(size_t)chain * SEQ + c * 128 + 127];
#pragma unroll
        for (int i = 0; i < 8; ++i) { const int ch = tg + 256 * i, r = ch >> 4, cc = ch & 15;
            const v4u x = *(const v4u*)(Z_ + (row0 + r) * NZ + ZC_VM + h * 128 + cc * 8); *(LAS v4u*)(Vt + r * 320 + cc * 16) = x; }
#pragma unroll
        for (int i = 0; i < 4; ++i) { const int ch = tg + 256 * i, r = ch >> 3, cc = ch & 7;
            const v4u x = *(const v4u*)(Z_ + (row0 + r) * NZ + ZC_KM + h * 64 + cc * 8);
            const float wg = __expf(fminf(sac[r] - mxe, 0.f)) * 0.125f;
            v4u o; o.x = pk2(pg8::bf_lo(x.x) * wg, pg8::bf_hi(x.x) * wg); o.y = pk2(pg8::bf_lo(x.y) * wg, pg8::bf_hi(x.y) * wg); o.z = pk2(pg8::bf_lo(x.z) * wg, pg8::bf_hi(x.z) * wg); o.w = pk2(pg8::bf_lo(x.w) * wg, pg8::bf_hi(x.w) * wg);
            *(LAS v4u*)(Kt + r * 192 + cc * 16) = o; }
        __syncthreads();
        f32x16 U0, U1;
#pragma unroll
        for (int r = 0; r < 16; ++r) { U0[r] = 0.f; U1[r] = 0.f; }
        const lds_cptr vb = (lds_cptr)Vt + (8 * hh + q) * 320 + (32 * w4 + 16 * blk + 4 * p) * 2;
        const lds_cptr kb = (lds_cptr)Kt + (8 * hh + q) * 192 + (16 * blk + 4 * p) * 2;
#pragma unroll
        for (int ks = 0; ks < 8; ++ks) {
            const bf16x8 af = tr_frag(vb + (16 * ks) * 320, vb + (16 * ks + 4) * 320);
            const bf16x8 b0 = tr_frag(kb + (16 * ks) * 192, kb + (16 * ks + 4) * 192);
            const bf16x8 b1 = tr_frag(kb + (16 * ks) * 192 + 64, kb + (16 * ks + 4) * 192 + 64);
            U0 = __builtin_amdgcn_mfma_f32_32x32x16_bf16(af, b0, U0, 0, 0, 0);
            U1 = __builtin_amdgcn_mfma_f32_32x32x16_bf16(af, b1, U1, 0, 0, 0);
        }
        float* Ug = UB_ + (size_t)it * 8256;
#pragma unroll
        for (int r = 0; r < 16; ++r) { const int v = 32 * w4 + crow(r, hh); Ug[v * 64 + l31] = U0[r]; Ug[v * 64 + 32 + l31] = U1[r]; }
        float ps = 0.f;
#pragma unroll 8
        for (int s_ = 0; s_ < 32; ++s_) ps += bf2f(*(const LAS unsigned short*)(Kt + (32 * w4 + s_) * 192 + lane * 2));
        part[w4 * 64 + lane] = ps;
        __syncthreads();
        if (w4 == 0) Ug[8192 + lane] = (part[lane] + part[64 + lane]) + (part[128 + lane] + part[192 + lane]);
        __syncthreads();
    }
}
__device__ __forceinline__ void p2b_scan(Frame& F) {
    const int lane = lane_id_fresh(); const int gt = (int)blockIdx.x * (NWAVES * 64) + F.wave * 64 + lane, NGT = F.G * NWAVES * 64;
    const float* SMX = SC_ + 8 * SEQ; const float* SMT = SC_ + 16 * SEQ;
    typedef float f32x2 __attribute__((ext_vector_type(2)));
    for (int e2 = gt; e2 < 8 * 4128; e2 += NGT) { const int chain = e2 / 4128, pr = e2 % 4128, el = 2 * pr;
        const float* ub = UB_ + (size_t)chain * 64 * 8256 + el; const float* mx = SMX + (size_t)chain * SEQ + 127;
        float st0 = 0.f, st1 = 0.f, mprev = 0.f;
        for (int c0 = 0; c0 < 64; c0 += 8) { f32x2 u[8]; float m8[8];
#pragma unroll
            for (int k = 0; k < 8; ++k) { u[k] = *(const f32x2*)(ub + (size_t)(c0 + k) * 8256); m8[k] = mx[(c0 + k) * 128]; }
#pragma unroll
            for (int k = 0; k < 8; ++k) { const size_t item = (size_t)chain * 64 + c0 + k;
                if (pr < 4096) *(unsigned*)(CP_ + item * 8192 + el) = pk2(st0, st1); else *(f32x2*)(NP_ + item * 64 + (el - 8192)) = (f32x2){st0, st1};
                const float dec = __expf(mprev - m8[k]); st0 = dec * st0 + u[k].x; st1 = dec * st1 + u[k].y; mprev = m8[k]; } }
        if (pr < 4096) *(f32x2*)(out_ + OFF_PC + (size_t)chain * 8192 + el) = (f32x2){st0, st1}; else *(f32x2*)(out_ + OFF_PN + (size_t)chain * 64 + (el - 8192)) = (f32x2){st0, st1};
        if (pr == 0) out_[OFF_PM + chain] = SMT[(size_t)chain * SEQ + SEQ - 1];
    }
}
__device__ __forceinline__ void p2c_md(Frame& F) {
    const int lane = lane_id_fresh(); const int grp = F.wave >> 2, w4 = F.wave & 3, hh = lane >> 5, l31 = lane & 31, tg = w4 * 64 + lane;
    LAS unsigned char* Vt = F.lds + RING_OFF + grp * 65536; LAS float* tabA = (LAS float*)(Vt + 40960);
    const float* SA = SC_; const float* SMX = SC_ + 8 * SEQ; const float* SMT = SC_ + 16 * SEQ;
    const int q = (lane & 15) >> 2, p = lane & 3, blk = (lane >> 4) & 1;
    for (int it0 = (int)blockIdx.x * 2; it0 < 512; it0 += 2 * F.G) {
        const int it = it0 + grp, chain = it >> 6, c = it & 63, b = chain >> 2, h = chain & 3;
        const size_t row0 = (size_t)b * SEQ + (size_t)c * 128; const size_t sc0 = (size_t)chain * SEQ + c * 128;
#pragma unroll
        for (int i = 0; i < 8; ++i) { const int ch = tg + 256 * i, r = ch >> 4, cc = ch & 15;
            const v4u x = *(const v4u*)(Z_ + (row0 + r) * NZ + ZC_VM + h * 128 + cc * 8); *(LAS v4u*)(Vt + r * 320 + cc * 16) = x; }
        if (tg < 128) tabA[tg] = SA[sc0 + tg];
        __syncthreads();
        const int t = 32 * w4 + l31; const size_t row = row0 + t;
        const float mxt = SMX[sc0 + t], mt = SMT[sc0 + t], mxp = (c == 0) ? 0.f : SMX[sc0 - 1];
        const float inter = __expf(fminf(mxp - mxt, 0.f));
        bf16x8 qf[4];
#pragma unroll
        for (int ks = 0; ks < 4; ++ks) qf[ks] = *(const bf16x8*)(Z_ + row * NZ + ZC_QM + h * 64 + 16 * ks + 8 * hh);
        f32x16 O[4];
#pragma unroll
        for (int vb = 0; vb < 4; ++vb)
#pragma unroll
            for (int r = 0; r < 16; ++r) O[vb][r] = 0.f;
        const bf16* cp = CP_ + (size_t)it * 8192;
#pragma unroll
        for (int vb = 0; vb < 4; ++vb)
#pragma unroll
            for (int ks = 0; ks < 4; ++ks) { const bf16x8 cf = *(const bf16x8*)(cp + (32 * vb + l31) * 64 + 16 * ks + 8 * hh);
                O[vb] = __builtin_amdgcn_mfma_f32_32x32x16_bf16(cf, qf[ks], O[vb], 0, 0, 0); }
#pragma unroll
        for (int vb = 0; vb < 4; ++vb)
#pragma unroll
            for (int r = 0; r < 16; ++r) O[vb][r] *= inter;
        const float* np = NP_ + (size_t)it * 64;
        float nq = 0.f;
#pragma unroll
        for (int ks = 0; ks < 4; ++ks) { const f32x4 n0 = *(const f32x4*)(np + 16 * ks + 8 * hh), n1 = *(const f32x4*)(np + 16 * ks + 8 * hh + 4);
            nq += bf2f((unsigned short)qf[ks][0]) * n0.x + bf2f((unsigned short)qf[ks][1]) * n0.y + bf2f((unsigned short)qf[ks][2]) * n0.z + bf2f((unsigned short)qf[ks][3]) * n0.w
                + bf2f((unsigned short)qf[ks][4]) * n1.x + bf2f((unsigned short)qf[ks][5]) * n1.y + bf2f((unsigned short)qf[ks][6]) * n1.z + bf2f((unsigned short)qf[ks][7]) * n1.w; }
        nq += __shfl_xor(nq, 32);
        float den = inter * nq, dsum = 0.f;
        const lds_cptr vbase = (lds_cptr)Vt + (4 * hh + q) * 320 + (16 * blk + 4 * p) * 2;
        for (int j = 0; j <= w4; ++j) {
            f32x16 X;
#pragma unroll
            for (int r = 0; r < 16; ++r) X[r] = 0.f;
#pragma unroll
            for (int ks = 0; ks < 4; ++ks) { const bf16x8 kf = *(const bf16x8*)(Z_ + (row0 + 32 * j + l31) * NZ + ZC_KM + h * 64 + 16 * ks + 8 * hh);
                X = __builtin_amdgcn_mfma_f32_32x32x16_bf16(kf, qf[ks], X, 0, 0, 0); }
            int l31v = l31, hhv = hh; asm volatile("" : "+v"(l31v), "+v"(hhv));
#pragma unroll
            for (int r = 0; r < 16; ++r) { const int sl = crow(r, hhv); const float a = tabA[32 * j + sl];
                float w = X[r] * 0.125f * __expf(fminf(a - mxt, 0.f)); if (j == w4 && sl > l31v) w = 0.f; dsum += w; X[r] = w; }
            v4u pw0, pw1;
            pw0.x = pg8::cvt_pk_bf16(X[0], X[1]); pw0.y = pg8::cvt_pk_bf16(X[2], X[3]); pw0.z = pg8::cvt_pk_bf16(X[4], X[5]); pw0.w = pg8::cvt_pk_bf16(X[6], X[7]);
            pw1.x = pg8::cvt_pk_bf16(X[8], X[9]); pw1.y = pg8::cvt_pk_bf16(X[10], X[11]); pw1.z = pg8::cvt_pk_bf16(X[12], X[13]); pw1.w = pg8::cvt_pk_bf16(X[14], X[15]);
            const bf16x8 pf0 = __builtin_bit_cast(bf16x8, pw0), pf1 = __builtin_bit_cast(bf16x8, pw1);
            const lds_cptr vj = vbase + (32 * j) * 320;
#pragma unroll
            for (int vb = 0; vb < 4; ++vb) {
                const bf16x8 vf0 = tr_frag(vj + 64 * vb, vj + 8 * 320 + 64 * vb);
                const bf16x8 vf1 = tr_frag(vj + 16 * 320 + 64 * vb, vj + 24 * 320 + 64 * vb);
                O[vb] = __builtin_amdgcn_mfma_f32_32x32x16_bf16(vf0, pf0, O[vb], 0, 0, 0);
                O[vb] = __builtin_amdgcn_mfma_f32_32x32x16_bf16(vf1, pf1, O[vb], 0, 0, 0);
            }
        }
        dsum += __shfl_xor(dsum, 32); den += dsum;
        const float rinv = 1.0f / fmaxf(fabsf(den), __expf(-mt));
        float ss = 0.f;
#pragma unroll
        for (int vb = 0; vb < 4; ++vb)
#pragma unroll
            for (int r = 0; r < 16; ++r) { O[vb][r] *= rinv; ss += O[vb][r] * O[vb][r]; }
        ss += __shfl_xor(ss, 32);
        const float rs = 1.0f / sqrtf(ss * (1.0f / 128.0f) + EPS);
#pragma unroll
        for (int vb = 0; vb < 4; ++vb)
#pragma unroll
            for (int rq = 0; rq < 4; ++rq) { const int v0 = 32 * vb + 8 * rq + 4 * hh;
                const v2u ow = *(const v2u*)(Z_ + row * NZ + ZC_OM + h * 128 + v0); const f32x4 g4 = *(const f32x4*)(g_head_ + h * 128 + v0);
                const float y0 = O[vb][4 * rq + 0] * rs * g4.x * pg8::sigmoidf_(pg8::bf_lo(ow.x)), y1 = O[vb][4 * rq + 1] * rs * g4.y * pg8::sigmoidf_(pg8::bf_hi(ow.x));
                const float y2 = O[vb][4 * rq + 2] * rs * g4.z * pg8::sigmoidf_(pg8::bf_lo(ow.y)), y3 = O[vb][4 * rq + 3] * rs * g4.w * pg8::sigmoidf_(pg8::bf_hi(ow.y));
                v2u o; o.x = pg8::cvt_pk_bf16(y0, y1); o.y = pg8::cvt_pk_bf16(y2, y3);
                *(v2u*)(Y_ + row * DM + 512 + h * 128 + v0) = o; }
        __syncthreads();
    }
}
__device__ __forceinline__ void p2_attn(Frame& F) {
    const int lane = lane_id_fresh(); const int wave = F.wave, g = wave >> 1, i2 = wave & 1, hh = lane >> 5, l31 = lane & 31, tid = wave * 64 + lane;
    LAS unsigned char* Vt = F.lds + RING_OFF; LAS float* biasT = (LAS float*)(F.lds + RING_OFF + 40960) + wave * 128;
    const int q = (lane & 15) >> 2, p = lane & 3, blk = (lane >> 4) & 1;
    for (int it = (int)blockIdx.x; it < 512; it += F.G) {
        const int b = it >> 8, kvh = (it >> 7) & 1, tb = it & 127, T0 = tb * 64, hq = kvh * 4 + g;
        const size_t rb = (size_t)b * SEQ;
#pragma unroll
        for (int i = 0; i < 3; ++i) { const int ch = tid + 512 * i, r = ch >> 3, cc = ch & 7, kp = T0 - 128 + r;
            v4u x = (v4u){0u, 0u, 0u, 0u}; if (kp >= 0) x = *(const v4u*)(Z_ + (rb + kp) * NZ + ZC_VA + kvh * 64 + cc * 8);
            *(LAS v4u*)(Vt + r * 192 + cc * 16) = x; }
        biasT[lane] = rel_bias_[t5_bucket(lane) * 8 + hq]; biasT[lane + 64] = rel_bias_[t5_bucket(lane + 64) * 8 + hq];
        __syncthreads();
        const int t = T0 + 32 * i2 + l31; const size_t row = rb + t; const int S0 = T0 + 32 * i2 - 128;
        bf16x8 qf[4];
#pragma unroll
        for (int ks = 0; ks < 4; ++ks) qf[ks] = *(const bf16x8*)(Z_ + row * NZ + ZC_QA + hq * 64 + 16 * ks + 8 * hh);
        f32x16 X[5];
#pragma unroll
        for (int jb = 0; jb < 5; ++jb) { int kp = S0 + 32 * jb + l31; kp = kp < 0 ? 0 : kp;
#pragma unroll
            for (int r = 0; r < 16; ++r) X[jb][r] = 0.f;
#pragma unroll
            for (int ks = 0; ks < 4; ++ks) { const bf16x8 kf = *(const bf16x8*)(Z_ + (rb + kp) * NZ + ZC_KA + kvh * 64 + 16 * ks + 8 * hh);
                X[jb] = __builtin_amdgcn_mfma_f32_32x32x16_bf16(kf, qf[ks], X[jb], 0, 0, 0); } }
        const float sink = sinks_[hq];
        float m = sink;
        int l31v = l31, hhv = hh; asm volatile("" : "+v"(l31v), "+v"(hhv));
#pragma unroll
        for (int jb = 0; jb < 5; ++jb)
#pragma unroll
            for (int r = 0; r < 16; ++r) { const int sl = crow(r, hhv), dist = 128 + l31v - 32 * jb - sl;
                bool valid = (S0 + 32 * jb + sl >= 0); if (jb == 0) valid = valid && (sl > l31v); if (jb == 4) valid = (sl <= l31v);
                const float sc = valid ? X[jb][r] * 0.125f + biasT[dist & 127] : -1.0e30f; X[jb][r] = sc; m = fmaxf(m, sc); }
        m = fmaxf(m, __shfl_xor(m, 32));
        float l = 0.f;
#pragma unroll
        for (int jb = 0; jb < 5; ++jb)
#pragma unroll
            for (int r = 0; r < 16; ++r) { const float pv = __expf(X[jb][r] - m); X[jb][r] = pv; l += pv; }
        l += __shfl_xor(l, 32); l += __expf(sink - m);
        f32x16 O0, O1;
#pragma unroll
        for (int r = 0; r < 16; ++r) { O0[r] = 0.f; O1[r] = 0.f; }
        const lds_cptr vbase = (lds_cptr)Vt + (32 * i2 + 4 * hh + q) * 192 + (16 * blk + 4 * p) * 2;
#pragma unroll
        for (int jb = 0; jb < 5; ++jb) {
            v4u pw0, pw1;
            pw0.x = pg8::cvt_pk_bf16(X[jb][0], X[jb][1]); pw0.y = pg8::cvt_pk_bf16(X[jb][2], X[jb][3]); pw0.z = pg8::cvt_pk_bf16(X[jb][4], X[jb][5]); pw0.w = pg8::cvt_pk_bf16(X[jb][6], X[jb][7]);
            pw1.x = pg8::cvt_pk_bf16(X[jb][8], X[jb][9]); pw1.y = pg8::cvt_pk_bf16(X[jb][10], X[jb][11]); pw1.z = pg8::cvt_pk_bf16(X[jb][12], X[jb][13]); pw1.w = pg8::cvt_pk_bf16(X[jb][14], X[jb][15]);
            const bf16x8 pf0 = __builtin_bit_cast(bf16x8, pw0), pf1 = __builtin_bit_cast(bf16x8, pw1);
            const lds_cptr vj = vbase + (32 * jb) * 192;
            const bf16x8 v00 = tr_frag(vj, vj + 8 * 192), v01 = tr_frag(vj + 64, vj + 8 * 192 + 64);
            const bf16x8 v10 = tr_frag(vj + 16 * 192, vj + 24 * 192), v11 = tr_frag(vj + 16 * 192 + 64, vj + 24 * 192 + 64);
            O0 = __builtin_amdgcn_mfma_f32_32x32x16_bf16(v00, pf0, O0, 0, 0, 0); O1 = __builtin_amdgcn_mfma_f32_32x32x16_bf16(v01, pf0, O1, 0, 0, 0);
            O0 = __builtin_amdgcn_mfma_f32_32x32x16_bf16(v10, pf1, O0, 0, 0, 0); O1 = __builtin_amdgcn_mfma_f32_32x32x16_bf16(v11, pf1, O1, 0, 0, 0);
        }
        const float rl = 1.0f / l;
#pragma unroll
        for (int rq = 0; rq < 4; ++rq) { const int d0 = 8 * rq + 4 * hh;
            v2u o; o.x = pg8::cvt_pk_bf16(O0[4 * rq] * rl, O0[4 * rq + 1] * rl); o.y = pg8::cvt_pk_bf16(O0[4 * rq + 2] * rl, O0[4 * rq + 3] * rl);
            *(v2u*)(Y_ + row * DM + hq * 64 + d0) = o;
            o.x = pg8::cvt_pk_bf16(O1[4 * rq] * rl, O1[4 * rq + 1] * rl); o.y = pg8::cvt_pk_bf16(O1[4 * rq + 2] * rl, O1[4 * rq + 3] * rl);
            *(v2u*)(Y_ + row * DM + hq * 64 + 32 + d0) = o; }
        __syncthreads();
    }
}
__device__ __forceinline__ void p3_hnorm(Frame& F) {
    const int LN_ = lane_id_fresh(); const int TID_ = F.wave * 64 + LN_; (void)TID_;
    const int gw = F.vcu * NWAVES + F.wave, NGW = F.G * NWAVES, lane = LN_;
    for (int it = gw; it < NSAMP * 4; it += NGW) { const int sb = it >> 2, row = NTOK_P + sb, h = it & 3;
        const float a = HRS_[(size_t)sb * 512 + h * 128 + 2 * lane], b = HRS_[(size_t)sb * 512 + h * 128 + 2 * lane + 1];
        const float ss = wave_sum(a * a + b * b), rs = 1.0f / sqrtf(ss * (1.0f / 128.0f) + EPS);
        const unsigned ow = *(const unsigned*)(Z_ + (size_t)row * NZ + ZC_OM + h * 128 + 2 * lane);
        const float ya = a * rs * g_head_[h * 128 + 2 * lane] * pg8::sigmoidf_(pg8::bf_lo(ow)), yb = b * rs * g_head_[h * 128 + 2 * lane + 1] * pg8::sigmoidf_(pg8::bf_hi(ow));
        *(unsigned*)(Y_ + (size_t)row * DM + 512 + h * 128 + 2 * lane) = pk2(ya, yb); }
}
__device__ __forceinline__ void p6_norm_to_h(Frame& F) {
    const int LN_ = lane_id_fresh(); const int TID_ = F.wave * 64 + LN_; (void)TID_;
    const int gw = F.vcu * NWAVES + F.wave, NGW = F.G * NWAVES;
    for (int row = gw; row < NROWS; row += NGW) {
        const GAS f32x4* xr = (const GAS f32x4*)(out_ + OFF_Y + (size_t)row * DM) + LN_;
        f32x4 v[4]; float ss = 0.f;
#pragma unroll
        for (int j = 0; j < 4; ++j) { v[j] = xr[64 * j]; ss += (v[j].x * v[j].x + v[j].y * v[j].y) + (v[j].z * v[j].z + v[j].w * v[j].w); }
        ss = wave_sum(ss); const float rstd = 1.0f / sqrtf(ss * (1.0f / DM) + EPS);
        GAS unsigned long long* o8 = (GAS unsigned long long*)(H_ + (size_t)row * DM) + LN_;
#pragma unroll
        for (int j = 0; j < 4; ++j) { const f32x4 gg = *((const GAS f32x4*)g_ffn_ + 64 * j + LN_);
            o8[64 * j] = (unsigned long long)pk2(v[j].x * rstd * gg.x, v[j].y * rstd * gg.y) | ((unsigned long long)pk2(v[j].z * rstd * gg.z, v[j].w * rstd * gg.w) << 32); }
    }
}
__device__ __forceinline__ void p9_final_norm(Frame& F) {
    const int LN_ = lane_id_fresh(); const int TID_ = F.wave * 64 + LN_; (void)TID_;
    const int gw = F.vcu * NWAVES + F.wave, NGW = F.G * NWAVES;
    for (int row = gw; row < NROWS; row += NGW) {
        GAS f32x4* xr = (GAS f32x4*)(out_ + OFF_Y + (size_t)row * DM) + LN_;
        f32x4 v[4]; float ss = 0.f;
#pragma unroll
        for (int j = 0; j < 4; ++j) { v[j] = xr[64 * j]; ss += (v[j].x * v[j].x + v[j].y * v[j].y) + (v[j].z * v[j].z + v[j].w * v[j].w); }
        ss = wave_sum(ss); const float rstd = 1.0f / sqrtf(ss * (1.0f / DM) + EPS);
#pragma unroll
        for (int j = 0; j < 4; ++j) { const f32x4 gg = *((const GAS f32x4*)g_final_ + 64 * j + LN_); xr[64 * j] = v[j] * rstd * gg; }
    }
}

__global__ void __launch_bounds__(NWAVES * 64, 2) skel_fwd(Args args) {
    extern __shared__ __attribute__((aligned(16))) unsigned char lds[];
    Frame F;
    F.lds = (LAS unsigned char*)lds;
    F.MISC = (volatile LAS unsigned*)(F.lds + MISC_OFF);
    F.wave = __builtin_amdgcn_readfirstlane((int)threadIdx.x >> 6);
    F.G = gridDim.x; { const int bx = blockIdx.x; F.vcu = (F.G % 8 == 0) ? (bx % 8) * (F.G / 8) + bx / 8 : bx; }
    F.a = &args;
    gu32* ctl = (gu32*)(args.ws + WS_CTL);
    for (int u = (int)threadIdx.x; u < (LDS_BYTES - LDSCTL_OFF) / 4; u += NWAVES * 64) ((LAS unsigned*)(F.lds + LDSCTL_OFF))[u] = 0u;
    __syncthreads();
    const int lo = args.ph_lo, hi = args.ph_hi;
    const bool multi = (hi - lo) > 1;
    XcdBarrier bar; bar.bar = (unsigned*)(ctl + CW_BAR); bar.x = 0; bar.st = nullptr;
    if (multi) bar = xcd_barrier_post((unsigned*)(ctl + CW_BAR), F.MISC + 8);
#ifndef PH_MASK
#define PH_MASK 0x7ff
#endif
#define IN(k) (((PH_MASK >> (k)) & 1) && lo <= (k) && (k) < hi)
#define SEAM(k) do { if (IN(k) && IN((k) + 1)) xcd_barrier(bar); } while (0)

    if (IN(0)) { p0_prologue(F); SEAM(0); }
    if (IN(1)) {
        if ((int)blockIdx.x >= F.G - 8) chain_scan(F, (int)blockIdx.x - (F.G - 8));
        pg8::Gemm g{H_, W1_, MPAD, NG1, DM}; pg8::StaticOrder S; S.init(MPAD, NG1, F.G, (int)blockIdx.x);
        pg8::EpiIn E{Z_, R_, SMG_, out_};
        pg8::gemm_phase<pg8::EpiIn, pg8::StaticOrder, PG8_ALIGN, PG8_SP2, 0>(F.lds + RING_OFF, g, S, E, F.wave, lane_id_fresh());
        SEAM(1);
    }
    if (IN(2)) { p2a_mb(F); p2_attn(F); p2_simple(F); SEAM(2); }
    if (IN(3)) { p2b_scan(F); SEAM(3); }
    if (IN(4)) { p2c_md(F); p3_hnorm(F); SEAM(4); }
    if (IN(5)) {
        pg8::Gemm g{Y_, W2_, MPAD, DM, DM}; pg8::StaticOrder S; S.init(MPAD, DM, F.G, (int)blockIdx.x);
        pg8::EpiMix E{R_, SMG_, MIX_};
        pg8::gemm_phase<pg8::EpiMix, pg8::StaticOrder, PG8_ALIGN, PG8_SP2, 8>(F.lds + RING_OFF, g, S, E, F.wave, lane_id_fresh());
        SEAM(5);
    }
    if (IN(6)) {
        pg8::Gemm g{MIX_, W3_, MPAD, DM, DM}; pg8::StaticOrder S; S.init(MPAD, DM, F.G, (int)blockIdx.x);
        pg8::EpiRes E{xp_, xs_, out_ + OFF_Y};
        pg8::gemm_phase<pg8::EpiRes, pg8::StaticOrder, PG8_ALIGN, PG8_SP2, 0>(F.lds + RING_OFF, g, S, E, F.wave, lane_id_fresh());
        SEAM(6);
    }
    if (IN(7)) { p6_norm_to_h(F); SEAM(7); }
    if (IN(8)) {
        pg8::Gemm g{H_, W4_, MPAD, NFF2, DM}; pg8::StaticOrder S; S.init(MPAD, NFF2, F.G, (int)blockIdx.x);
        pg8::EpiSwiglu E{ACT_};
        pg8::gemm_phase<pg8::EpiSwiglu, pg8::StaticOrder, PG8_ALIGN, PG8_SP2, 0>(F.lds + RING_OFF, g, S, E, F.wave, lane_id_fresh());
        SEAM(8);
    }
    if (IN(9)) {
        pg8::Gemm g{ACT_, W5_, MPAD, DM, DFF}; pg8::StaticOrder S; S.init(MPAD, DM, F.G, (int)blockIdx.x);
        pg8::EpiRes E{out_ + OFF_Y, out_ + OFF_Y + (size_t)NTOK_P * DM, out_ + OFF_Y};
        pg8::gemm_phase<pg8::EpiRes, pg8::StaticOrder, PG8_ALIGN, PG8_SP2, 0>(F.lds + RING_OFF, g, S, E, F.wave, lane_id_fresh());
        SEAM(9);
    }
    if (IN(10)) { p9_final_norm(F); }
#undef IN
#undef SEAM
}

extern "C" void kernel_launch(void* const* d_in, const int* in_sizes, int n_in, void* d_out, int out_size, void* d_ws, size_t ws_size, hipStream_t stream) {
    static int grid = 0;
    if (grid == 0) {
        if (n_in != 21 || out_size != (int)OUT_END || ws_size < WS_END) { fprintf(stderr, "kernel_launch: unexpected shapes: n_in %d out %d ws %zu\n", n_in, out_size, ws_size); grid = -1; return; }
        int dev = 0, cus = 0, per_cu = 0;
        if (hipGetDevice(&dev) != hipSuccess || hipDeviceGetAttribute(&cus, hipDeviceAttributeMultiprocessorCount, dev) != hipSuccess) { grid = -1; return; }
        if (hipFuncSetAttribute((const void*)skel_fwd, hipFuncAttributeMaxDynamicSharedMemorySize, LDS_BYTES) != hipSuccess) { fprintf(stderr, "kernel_launch: hipFuncSetAttribute failed\n"); grid = -1; return; }
        if (hipOccupancyMaxActiveBlocksPerMultiprocessor(&per_cu, (const void*)skel_fwd, NWAVES * 64, LDS_BYTES) != hipSuccess || per_cu < 1)
            fprintf(stderr, "kernel_launch: note: occupancy query reports %d workgroups per CU\n", per_cu);
        (void)hipGetLastError();
        grid = cus;
    }
    if (grid < 0) return;
    if (hipMemsetAsync((char*)d_ws + WS_CTL, 0, CTL_ZERO_BYTES, stream) != hipSuccess) { fprintf(stderr, "kernel_launch: memset failed\n"); return; }
    Args a{};
    for (int i = 0; i < 21; ++i) a.in[i] = (const float*)d_in[i];
    a.out = (float*)d_out; a.ws = (unsigned char*)d_ws;
#if MK_ONE_LAUNCH
    a.ph_lo = 0; a.ph_hi = N_PHASES; a.li = 0;
    hipLaunchKernelGGL(skel_fwd, dim3(grid), dim3(NWAVES * 64), LDS_BYTES, stream, a);
#else
    for (int p = 0; p < N_PHASES; ++p) { a.ph_lo = p; a.ph_hi = p + 1; a.li = p;
        hipLaunchKernelGGL(skel_fwd, dim3(grid), dim3(NWAVES * 64), LDS_BYTES, stream, a); }
#endif
}
```
